# Optimizing an MI355X kernel written in HIP

```python
import jax, jax.numpy as jnp
from jax import lax
import numpy as np

D_MODEL = 1024
BATCH = 8
SEQ = 2048
DEPTH = 4
DEC_BATCH = 8
DEC_SEQ = 16
PAST_LEN = 4096

CHUNK = 64
GMLP_WIDTH = 1024
GMLP_HEADS = 8
GMLP_HEAD_DIM = GMLP_WIDTH // GMLP_HEADS
GMLP_CHUNK = 128
SSD_WIDTH = 1024
SSD_HEAD_DIM = 64
SSD_HEADS = SSD_WIDTH // SSD_HEAD_DIM
SSD_GROUPS = 2
SSD_HEADS_PER_GROUP = SSD_HEADS // SSD_GROUPS
SSD_STATE = 128
SSD_CONV = 4
SSD_CHUNK = 128
SSD_CONV_DIM = SSD_WIDTH + 2 * SSD_GROUPS * SSD_STATE
MIX_WIDTH = GMLP_WIDTH + SSD_WIDTH
D_IN_PROJ = 2 * GMLP_WIDTH + SSD_WIDTH + SSD_CONV_DIM + SSD_HEADS
D_FF = 4 * D_MODEL
ALPHA = (2 * DEPTH) ** 0.25
BETA = (8 * DEPTH) ** -0.25
LN_EPS = 1e-5
RMS_EPS = 1e-5

kernel_name = "hymba_gmlp_ssd_deepnorm_stream"


def layer_norm(x, g, b):
    xf = x.astype(jnp.float32)
    mu = jnp.mean(xf, axis=-1, keepdims=True)
    var = jnp.mean(jnp.square(xf - mu), axis=-1, keepdims=True)
    y = (xf - mu) * lax.rsqrt(var + LN_EPS) * g.astype(jnp.float32) + b.astype(jnp.float32)
    return y.astype(x.dtype)


def gated_rms_norm(y, z, g):
    bsz, L, _ = y.shape
    h = y.astype(jnp.float32) * jax.nn.silu(z.astype(jnp.float32))
    h = h.reshape(bsz, L, SSD_GROUPS, SSD_WIDTH // SSD_GROUPS)
    h = h * lax.rsqrt(jnp.mean(jnp.square(h), axis=-1, keepdims=True) + RMS_EPS)
    return (h.reshape(bsz, L, SSD_WIDTH) * g.astype(jnp.float32)).astype(z.dtype)


def gmlp_mix(u, v, ln_g, ln_b, w_s, b_s, offset):
    bsz, L, _ = v.shape
    u = jax.nn.gelu(u)
    v = layer_norm(jax.nn.gelu(v), ln_g, ln_b)
    q = min(L, GMLP_CHUNK)
    causal = jnp.tril(jnp.ones((GMLP_CHUNK, GMLP_CHUNK), dtype=bool))
    w = jnp.where(causal, w_s, jnp.zeros_like(w_s))[:, offset:offset + q, offset:offset + q]
    bq = b_s[:, offset:offset + q]
    vc = v.reshape(bsz, L // q, q, GMLP_HEADS, GMLP_HEAD_DIM)
    s = jnp.einsum('hts,bcshd->bcthd', w, vc) + bq.T[None, None, :, :, None]
    return u * s.reshape(bsz, L, GMLP_WIDTH), v


def causal_conv(xbc, conv_state, w, b):
    L = xbc.shape[1]
    xp = jnp.concatenate([conv_state.astype(xbc.dtype), xbc], axis=1)
    out = b + w[0] * xp[:, 0:L]
    for k in range(1, SSD_CONV):
        out = out + w[k] * xp[:, k:k + L]
    return jax.nn.silu(out), xp[:, -(SSD_CONV - 1):]


def ssd_scan(x, dt, a, bm, cm, h0):
    f32 = jnp.float32
    bsz, L = x.shape[:2]
    q = min(L, SSD_CHUNK)
    nc = L // q
    G, R, P, N = SSD_GROUPS, SSD_HEADS_PER_GROUP, SSD_HEAD_DIM, SSD_STATE
    xf = x.astype(f32).reshape(bsz, nc, q, G, R, P)
    dtc = dt.reshape(bsz, nc, q, G, R)
    bc = bm.astype(f32).reshape(bsz, nc, q, G, N)
    cc = cm.astype(f32).reshape(bsz, nc, q, G, N)
    acum = jnp.cumsum(dtc * a.reshape(G, R), axis=2)
    seg = acum[:, :, :, None] - acum[:, :, None, :]
    causal = jnp.tril(jnp.ones((q, q), dtype=bool))[:, :, None, None]
    decay = jnp.exp(jnp.where(causal, seg, -jnp.inf))
    cb = jnp.einsum('bcign,bcjgn->bcijg', cc, bc)
    y_diag = jnp.einsum('bcijg,bcijgr,bcjgr,bcjgrp->bcigrp', cb, decay, dtc, xf)
    dec_end = jnp.exp(acum[:, :, -1:] - acum)
    st = jnp.einsum('bcjgn,bcjgr,bcjgrp->bcgrpn', bc, dec_end * dtc, xf)
    block_decay = jnp.exp(acum[:, :, -1])

    def step(h, inp):
        s_c, d_c = inp
        return d_c[..., None, None] * h + s_c, h

    h_init = h0.astype(f32).reshape(bsz, G, R, P, N)
    h_final, h_starts = lax.scan(step, h_init, (jnp.moveaxis(st, 1, 0), jnp.moveaxis(block_decay, 1, 0)))
    h_starts = jnp.moveaxis(h_starts, 0, 1)
    y_off = jnp.einsum('bcign,bcgrpn,bcigr->bcigrp', cc, h_starts, jnp.exp(acum))
    y = (y_diag + y_off).reshape(bsz, L, SSD_HEADS, P)
    return y, h_final.reshape(bsz, SSD_HEADS, P, N)


def mixer(x, ssm_state, conv_state, offset, w_in, gmlp_ln_g, gmlp_ln_b, gmlp_ws, gmlp_bs,
          conv_w, conv_b, dt_bias, a_log, d_skip, ssd_norm_g, w_out):
    bsz, L, _ = x.shape
    proj = jnp.einsum('bld,de->ble', x, w_in)
    s1 = GMLP_WIDTH
    s2 = 2 * GMLP_WIDTH
    s3 = s2 + SSD_WIDTH
    s4 = s3 + SSD_CONV_DIM
    u, v, z, xbc, dt = proj[..., :s1], proj[..., s1:s2], proj[..., s2:s3], proj[..., s3:s4], proj[..., s4:]
    y_g, v_rows = gmlp_mix(u, v, gmlp_ln_g, gmlp_ln_b, gmlp_ws, gmlp_bs, offset)
    xbc, new_conv = causal_conv(xbc, conv_state, conv_w, conv_b)
    xs = xbc[..., :SSD_WIDTH].reshape(bsz, L, SSD_HEADS, SSD_HEAD_DIM)
    bm = xbc[..., SSD_WIDTH:SSD_WIDTH + SSD_GROUPS * SSD_STATE].reshape(bsz, L, SSD_GROUPS, SSD_STATE)
    cm = xbc[..., SSD_WIDTH + SSD_GROUPS * SSD_STATE:].reshape(bsz, L, SSD_GROUPS, SSD_STATE)
    dtp = jax.nn.softplus(dt.astype(jnp.float32) + dt_bias.astype(jnp.float32))
    a = -jnp.exp(a_log.astype(jnp.float32))
    y, new_ssm = ssd_scan(xs, dtp, a, bm, cm, ssm_state)
    y = y + d_skip.astype(jnp.float32)[:, None] * xs.astype(jnp.float32)
    y_s = gated_rms_norm(y.reshape(bsz, L, SSD_WIDTH), z, ssd_norm_g)
    out = jnp.einsum('ble,ed->bld', jnp.concatenate([y_g, y_s], axis=-1), w_out)
    return out, new_ssm.astype(ssm_state.dtype), new_conv, v_rows


def squared_relu_ffn(x, w1, w2):
    h = jnp.square(jax.nn.relu(jnp.einsum('bld,df->blf', x, w1)))
    return jnp.einsum('blf,fd->bld', h, w2)


def setup_inputs(seed: int = 0) -> dict:
    key = jax.random.key(seed)
    ks = jax.random.split(key, 24)
    f32 = jnp.float32
    nrm = lambda k, shp: jax.random.normal(k, shp, dtype=f32)
    dt0 = jnp.exp(jax.random.uniform(ks[9], (DEPTH, SSD_HEADS), minval=np.log(1e-3), maxval=np.log(1e-1)))
    return {
        'x_prompt': nrm(ks[0], (BATCH, SEQ, D_MODEL)),
        'x_sample': nrm(ks[1], (DEC_BATCH, DEC_SEQ, D_MODEL)),
        'state_ssm': 0.3 * nrm(ks[2], (DEPTH, DEC_BATCH, SSD_HEADS, SSD_HEAD_DIM, SSD_STATE)),
        'state_conv': nrm(ks[3], (DEPTH, DEC_BATCH, SSD_CONV - 1, SSD_CONV_DIM)),
        'w_in': nrm(ks[4], (DEPTH, D_MODEL, D_IN_PROJ)) * D_MODEL ** -0.5,
        'gmlp_ln_g': 1.0 + 0.02 * nrm(ks[5], (DEPTH, GMLP_WIDTH)),
        'gmlp_ln_b': 0.02 * nrm(ks[6], (DEPTH, GMLP_WIDTH)),
        'gmlp_ws': nrm(ks[7], (DEPTH, GMLP_HEADS, GMLP_CHUNK, GMLP_CHUNK)) * GMLP_CHUNK ** -0.5,
        'gmlp_bs': 1.0 + 0.02 * nrm(ks[8], (DEPTH, GMLP_HEADS, GMLP_CHUNK)),
        'conv_w': nrm(ks[10], (DEPTH, SSD_CONV, SSD_CONV_DIM)) * SSD_CONV ** -0.5,
        'conv_b': 0.02 * nrm(ks[11], (DEPTH, SSD_CONV_DIM)),
        'dt_bias': dt0 + jnp.log(-jnp.expm1(-dt0)),
        'a_log': jnp.log(jax.random.uniform(ks[12], (DEPTH, SSD_HEADS), minval=1.0, maxval=16.0)),
        'd_skip': 1.0 + 0.02 * nrm(ks[13], (DEPTH, SSD_HEADS)),
        'ssd_norm_g': 1.0 + 0.02 * nrm(ks[14], (DEPTH, SSD_WIDTH)),
        'w_out': nrm(ks[15], (DEPTH, MIX_WIDTH, D_MODEL)) * (MIX_WIDTH ** -0.5 * BETA),
        'ln1_g': 1.0 + 0.02 * nrm(ks[16], (DEPTH, D_MODEL)),
        'ln1_b': 0.02 * nrm(ks[17], (DEPTH, D_MODEL)),
        'w_ff1': nrm(ks[18], (DEPTH, D_MODEL, D_FF)) * (D_MODEL ** -0.5 * BETA),
        'w_ff2': nrm(ks[19], (DEPTH, D_FF, D_MODEL)) * (D_FF ** -0.5 * BETA),
        'ln2_g': 1.0 + 0.02 * nrm(ks[20], (DEPTH, D_MODEL)),
        'ln2_b': 0.02 * nrm(ks[21], (DEPTH, D_MODEL)),
    }


def reference(x_prompt, x_sample, state_ssm, state_conv, w_in, gmlp_ln_g, gmlp_ln_b, gmlp_ws, gmlp_bs,
              conv_w, conv_b, dt_bias, a_log, d_skip, ssd_norm_g, w_out, ln1_g, ln1_b, w_ff1, w_ff2,
              ln2_g, ln2_b):
    bp = x_prompt.shape[0]
    zero_ssm = jnp.zeros((bp, SSD_HEADS, SSD_HEAD_DIM, SSD_STATE), x_prompt.dtype)
    zero_conv = jnp.zeros((bp, SSD_CONV - 1, SSD_CONV_DIM), x_prompt.dtype)
    sample_offset = PAST_LEN % GMLP_CHUNK
    xp, xs = x_prompt, x_sample
    ssm_p, conv_p, ssm_s, conv_s, v_s = [], [], [], [], []
    for l in range(DEPTH):
        lw = (w_in[l], gmlp_ln_g[l], gmlp_ln_b[l], gmlp_ws[l], gmlp_bs[l], conv_w[l], conv_b[l],
              dt_bias[l], a_log[l], d_skip[l], ssd_norm_g[l], w_out[l])
        hp, sp, cp, _ = mixer(xp, zero_ssm, zero_conv, 0, *lw)
        hs, ss, cs, vs = mixer(xs, state_ssm[l], state_conv[l], sample_offset, *lw)
        xp = layer_norm(ALPHA * xp + hp, ln1_g[l], ln1_b[l])
        xs = layer_norm(ALPHA * xs + hs, ln1_g[l], ln1_b[l])
        xp = layer_norm(ALPHA * xp + squared_relu_ffn(xp, w_ff1[l], w_ff2[l]), ln2_g[l], ln2_b[l])
        xs = layer_norm(ALPHA * xs + squared_relu_ffn(xs, w_ff1[l], w_ff2[l]), ln2_g[l], ln2_b[l])
        ssm_p.append(sp)
        conv_p.append(cp)
        ssm_s.append(ss)
        conv_s.append(cs)
        v_s.append(vs)
    return (xp, xs, jnp.stack(ssm_p), jnp.stack(conv_p), jnp.stack(ssm_s), jnp.stack(conv_s), jnp.stack(v_s))
```

```cpp
#include <hip/hip_runtime.h>
#include <hip/hip_cooperative_groups.h>
#include <cstdio>
namespace cg = cooperative_groups;
namespace pg8 {
#define PG8_LAS __attribute__((address_space(3)))
typedef unsigned short bf16_t;
typedef short bf16x8 __attribute__((ext_vector_type(8)));
typedef float f32x4 __attribute__((ext_vector_type(4)));
typedef unsigned u32x4 __attribute__((ext_vector_type(4)));
constexpr int BM = 256, BK = 64, HALF = 128, HTB = HALF * BK * 2  , STAGE_BYTES = 8 * HTB, NXCD = 8, WGM = 8;

__host__ __device__ __forceinline__ int lds_byte(int r, int c) { const int st = (r >> 4) * 2 + (c >> 5), rr = r & 15, cc = c & 31, ob = rr * 64 + cc * 2; return st * 1024 + (ob ^ (((ob >> 9) & 1) << 5)); }
__host__ __device__ __forceinline__ void stage_rc(int b, int& R, int& C) { const int st = b / 1024, sb = b % 1024, swz = sb ^ (((sb >> 9) & 1) << 5); R = (st >> 1) * 16 + swz / 64; C = (st & 1) * 32 + (swz % 64) / 2; }
__host__ __device__ __forceinline__ int perm32(int rho) { const int n = rho >> 4, i = rho & 15; return 8 * (i >> 2) + 4 * n + (i & 3); }

struct Unit { int pm, pn; };
struct Gemm { const bf16_t* A; const bf16_t* Bt; int M, N, K; };

struct StaticOrder {
    int nM, nN, nwg, G, c;
    __host__ __device__ void init(int M, int N, int G_, int c_) { nM = M / BM; nN = N / BM; nwg = nM * nN; G = G_; c = c_; }
    __host__ __device__ bool next(int i, Unit& u) const {
        const long L = (long)i * G + c; if (L >= nwg) return false;
        int wgid = (int)L; { const int q = nwg / NXCD, r = nwg % NXCD, xcd = wgid % NXCD, off = wgid / NXCD; wgid = (xcd < r ? xcd * (q + 1) : r * (q + 1) + (xcd - r) * q) + off; }
        const int nig = WGM * nN, gid = wgid / nig, fm = gid * WGM, gsz = (nM - fm) < WGM ? (nM - fm) : WGM;
        u.pm = fm + ((wgid % nig) % gsz); u.pn = (wgid % nig) / gsz; return true;
    }
    __device__ __forceinline__ void a_ready(const Unit&) const {}
    __device__ __forceinline__ void done(const Unit&) const {}
};
__device__ __forceinline__ unsigned cvt_pk_bf16(float lo, float hi) { unsigned r; asm volatile("v_cvt_pk_bf16_f32 %0, %1, %2" : "=v"(r) : "v"(lo), "v"(hi)); return r; }
template <class Epi, class Sched, bool STAMP = false>
__device__ __forceinline__ void gemm_phase(PG8_LAS unsigned char* lds, const Gemm g, const Sched& S, const Epi& E, unsigned long long* stamps) {
    int tid_ = threadIdx.x; asm volatile("" : "+v"(tid_)); const int tid = tid_, wid = __builtin_amdgcn_readfirstlane(tid >> 6), lane = tid & 63, wr = wid >> 2, wc = wid & 3, fr = lane & 15, fq = lane >> 4;
    const int K = g.K, nt = K / BK;
    int ts_lo = 0, ts_hi = 0, nts = 0; const unsigned long long rt_entry = STAMP ? (unsigned long long)wall_clock64() : 0ull;
#define PG8_STAMP() do { if (STAMP && wid == 0 && nts < 64) { const unsigned long long _c = (unsigned long long)clock64(); \
        ts_lo = (lane == nts) ? (int)(unsigned)_c : ts_lo; ts_hi = (lane == nts) ? (int)(unsigned)(_c >> 32) : ts_hi; ++nts; } } while (0)
    PG8_STAMP();
    unsigned voffA[2], voffB[2];
#pragma unroll
    for (int i = 0; i < 2; ++i) { int R, C; stage_rc(tid * 16 + i * 8192, R, C); const int Rb = Epi::PERM ? ((R & ~31) + perm32(R & 31)) : R;
        voffA[i] = (unsigned)(R * K + C) * 2u; voffB[i] = (unsigned)(Rb * K + C) * 2u; }
    const size_t kstep = (size_t)(BK * 2);
    const size_t hstep = (size_t)HALF * K * 2;
    const size_t tstep = 2 * hstep;
    const unsigned ldsw = (unsigned)wid * 1024u;
    const int aoff = lds_byte(wr * 64 + fr, fq * 8), boff = lds_byte(wc * 32 + fr, fq * 8);
#define PG8_SA(b, h) (((b) * 2 + (h)) * HTB)
#define PG8_SB(b, h) ((4 + (b) * 2 + (h)) * HTB)
#define PG8_STAGE(bufoff, gbase, voff) do { _Pragma("unroll") for (int _i = 0; _i < 2; ++_i) \
        __builtin_amdgcn_global_load_lds((const unsigned*)((const char*)(gbase) + (voff)[_i]), (PG8_LAS unsigned*)(lds + (bufoff) + ldsw + _i * 8192), 16, 0, 0); } while (0)
#define PG8_LDA(dst, b, h) do { _Pragma("unroll") for (int m = 0; m < 4; ++m) _Pragma("unroll") for (int k = 0; k < 2; ++k) dst[m][k] = *(const PG8_LAS bf16x8*)(lds + PG8_SA(b, h) + aoff + m * 2048 + k * 1024); } while (0)
#define PG8_LDB(dst, b, h) do { _Pragma("unroll") for (int n = 0; n < 2; ++n) _Pragma("unroll") for (int k = 0; k < 2; ++k) dst[n][k] = *(const PG8_LAS bf16x8*)(lds + PG8_SB(b, h) + boff + n * 2048 + k * 1024); } while (0)
#define PG8_MMA(ai, bj, At, Bt) do { __builtin_amdgcn_s_setprio(1); _Pragma("unroll") for (int m = 0; m < 4; ++m) _Pragma("unroll") for (int n = 0; n < 2; ++n) _Pragma("unroll") for (int k = 0; k < 2; ++k) \
        acc[ai][bj][m][n] = __builtin_amdgcn_mfma_f32_16x16x32_bf16(Bt[n][k], At[m][k], acc[ai][bj][m][n], 0, 0, 0); __builtin_amdgcn_s_setprio(0); } while (0)
#define PG8_WAIT_V(n) asm volatile("s_waitcnt vmcnt(" #n ")" ::: "memory")
#define PG8_WAIT_L(n) asm volatile("s_waitcnt lgkmcnt(" #n ")" ::: "memory")
#define PG8_BAR __builtin_amdgcn_s_barrier()
#define PG8_SCHED __builtin_amdgcn_sched_barrier(0)
    Unit cur, nxt; int ui = 0;
    if (!S.next(0, cur)) return;
    f32x4 acc[2][2][4][2];
#pragma unroll
    for (int a = 0; a < 2; ++a)
#pragma unroll
        for (int b = 0; b < 2; ++b)
#pragma unroll
            for (int m = 0; m < 4; ++m)
#pragma unroll
                for (int n = 0; n < 2; ++n) acc[a][b][m][n] = (f32x4){0.f, 0.f, 0.f, 0.f};
    bf16x8 At[4][2], B0[2][2], B1[2][2];
    const char* cA = (const char*)g.A + (size_t)cur.pm * tstep; const char* cB = (const char*)g.Bt + (size_t)cur.pn * tstep;
    S.a_ready(cur);
    PG8_STAGE(PG8_SB(0, 0), cB, voffB); PG8_STAGE(PG8_SA(0, 0), cA, voffA); PG8_STAGE(PG8_SB(0, 1), cB + hstep, voffB); PG8_STAGE(PG8_SA(0, 1), cA + hstep, voffA);
    if (wr == 1) PG8_BAR;
    PG8_WAIT_V(4); PG8_BAR;
    PG8_STAGE(PG8_SB(1, 0), cB + kstep, voffB); PG8_STAGE(PG8_SA(1, 0), cA + kstep, voffA); PG8_STAGE(PG8_SB(1, 1), cB + hstep + kstep, voffB);
    PG8_WAIT_V(6); PG8_BAR;
    PG8_STAMP();
    for (;;) {
        const bool has_next = S.next(ui + 1, nxt);
        const char* nA = has_next ? (const char*)g.A + (size_t)nxt.pm * tstep : cA; const char* nB = has_next ? (const char*)g.Bt + (size_t)nxt.pn * tstep : cB;
        for (int t = 0; t < nt; t += 2) {
            const bool last = (t == nt - 2);
            const char* a1 = cA + (size_t)(t + 1) * kstep;
            const char* a2 = last ? nA : cA + (size_t)(t + 2) * kstep; const char* b2 = last ? nB : cB + (size_t)(t + 2) * kstep;
            const char* a3 = a2 + kstep; const char* b3 = b2 + kstep;
            if (last && has_next) S.a_ready(nxt);
            PG8_LDB(B0, 0, 0); PG8_SCHED; PG8_LDA(At, 0, 0); PG8_STAGE(PG8_SA(1, 1), a1 + hstep, voffA);
            PG8_WAIT_L(8); PG8_BAR; PG8_WAIT_L(0); PG8_MMA(0, 0, At, B0); PG8_BAR; PG8_SCHED;
            PG8_LDB(B1, 0, 1); PG8_STAGE(PG8_SB(0, 0), b2, voffB);
            PG8_BAR; PG8_WAIT_L(0); PG8_MMA(0, 1, At, B1); PG8_BAR;
            PG8_LDA(At, 0, 1); PG8_STAGE(PG8_SA(0, 0), a2, voffA);
            PG8_BAR; PG8_WAIT_L(0); PG8_MMA(1, 0, At, B0); PG8_BAR; PG8_SCHED;
            PG8_STAGE(PG8_SB(0, 1), b2 + hstep, voffB);
            PG8_WAIT_V(6); PG8_BAR; PG8_MMA(1, 1, At, B1); PG8_BAR;
            PG8_LDB(B0, 1, 0); PG8_SCHED; PG8_LDA(At, 1, 0); PG8_STAGE(PG8_SA(0, 1), a2 + hstep, voffA);
            PG8_WAIT_L(8); PG8_BAR; PG8_WAIT_L(0); PG8_MMA(0, 0, At, B0); PG8_BAR; PG8_SCHED;
            PG8_LDB(B1, 1, 1); PG8_STAGE(PG8_SB(1, 0), b3, voffB);
            PG8_BAR; PG8_WAIT_L(0); PG8_MMA(0, 1, At, B1); PG8_BAR;
            PG8_LDA(At, 1, 1); PG8_STAGE(PG8_SA(1, 0), a3, voffA);
            PG8_BAR; PG8_WAIT_L(0); PG8_MMA(1, 0, At, B0); PG8_BAR; PG8_SCHED;
            PG8_STAGE(PG8_SB(1, 1), b3 + hstep, voffB);
            PG8_WAIT_V(6); PG8_BAR; PG8_MMA(1, 1, At, B1); PG8_BAR;
        }
        PG8_STAMP();
        if constexpr (!Epi::AFTER_DRAIN) { E(acc, cur, wr, wc, fr, fq); S.done(cur); }
        PG8_STAMP();
        if (!has_next) break;
#pragma unroll
        for (int a = 0; a < 2; ++a)
#pragma unroll
            for (int b = 0; b < 2; ++b)
#pragma unroll
                for (int m = 0; m < 4; ++m)
#pragma unroll
                    for (int n = 0; n < 2; ++n) acc[a][b][m][n] = (f32x4){0.f, 0.f, 0.f, 0.f};
        cur = nxt; cA = nA; cB = nB; ++ui;
    }
    PG8_WAIT_V(0);
    if (wr == 0) PG8_BAR;
    PG8_BAR;
    if constexpr (Epi::AFTER_DRAIN) { E.fused(acc, cur, wr, wc, fr, fq, lds, wid, lane); S.done(cur); }
    PG8_STAMP();
    if (STAMP && wid == 0) { stamps[lane] = lane < nts ? (((unsigned long long)(unsigned)ts_hi << 32) | (unsigned)ts_lo) : 0ull;
        if (lane == 62) stamps[62] = rt_entry; if (lane == 63) stamps[63] = (unsigned long long)wall_clock64(); }
#undef PG8_STAMP
#undef PG8_SA
#undef PG8_SB
#undef PG8_STAGE
#undef PG8_LDA
#undef PG8_LDB
#undef PG8_MMA
#undef PG8_WAIT_V
#undef PG8_WAIT_L
#undef PG8_BAR
#undef PG8_SCHED
}
}
using pg8::bf16_t; using pg8::bf16x8; using pg8::f32x4; using pg8::u32x4; using pg8::cvt_pk_bf16; using pg8::Unit;
#define LAS __attribute__((address_space(3)))
typedef unsigned u32x2 __attribute__((ext_vector_type(2)));
typedef float f32x2 __attribute__((ext_vector_type(2)));

constexpr int DM = 1024, NB = 8, SEQ = 2048, DEPTH = 4, DSEQ = 16;
constexpr int TPR = NB * SEQ, T = TPR + NB * DSEQ, TP = 16640;
constexpr int NIN = 4624, NINP = 4864, XW = 1536, DFF = 4096, MIXW = 2048;
constexpr float ALPHA = 1.6817928305074290f;
constexpr float LN_EPS = 1e-5f, RMS_EPS = 1e-5f;
constexpr size_t SZ_ACT = (size_t)TP * 1024 * 2;
constexpr size_t WS_XB = 0;
constexpr size_t WS_UG = WS_XB + SZ_ACT, WS_VG = WS_UG + SZ_ACT, WS_Z = WS_VG + SZ_ACT, WS_XBC = WS_Z + SZ_ACT;
constexpr size_t WS_H = WS_UG;
constexpr size_t WS_MIX = WS_XBC + (size_t)TP * XW * 2;
constexpr size_t WS_DT = WS_MIX + (size_t)TP * MIXW * 2;
constexpr size_t WS_SS = WS_DT + (size_t)TP * 16 * 4;
constexpr size_t WS_WIN = WS_SS + (size_t)TP * 16 * 4;
constexpr size_t WS_WOUT = WS_WIN + (size_t)NINP * 1024 * 2;
constexpr size_t WS_WF1 = WS_WOUT + (size_t)1024 * 2048 * 2;
constexpr size_t WS_WF2 = WS_WF1 + (size_t)4096 * 1024 * 2;
constexpr size_t WS_GW = WS_WF2 + (size_t)4096 * 1024 * 2;
constexpr size_t WS_END = WS_GW + (size_t)DEPTH * 8 * 128 * 128 * 2;
static_assert(WS_XBC + (size_t)TP * XW * 2 - WS_UG >= (size_t)TP * DFF * 2, "H alias");
constexpr size_t O_YP = 0, O_YS = 16777216, O_SSMP = 16908288, O_CONVP = 21102592, O_SSMS = 21250048, O_CONVS = 25444352, O_VS = 25591808;
constexpr int LDS_BYTES = 143360;

struct Params {
  const float* in[22]; float* out; unsigned char* ws; int ph_lo, ph_hi;
};
struct InProxy { const Params& p; int z; __device__ __forceinline__ const float* operator[](int k) const { return p.in[k + z]; } };
struct Lp { InProxy in; unsigned char* ws; float* out; int tid, bid, G; };

__device__ __forceinline__ float bf2f(unsigned short b) { return __uint_as_float(((unsigned)b) << 16); }
__device__ __forceinline__ float lo2f(unsigned w) { return __uint_as_float(w << 16); }
__device__ __forceinline__ float hi2f(unsigned w) { return __uint_as_float(w & 0xffff0000u); }
__device__ __forceinline__ unsigned short f2bf(float f) { return (unsigned short)(cvt_pk_bf16(f, 0.f) & 0xffffu); }
__device__ __forceinline__ float gelu_t(float x) { const float u = 0.7978845608f * (x + 0.044715f * x * x * x); return x * __builtin_amdgcn_rcpf(1.0f + __builtin_amdgcn_exp2f(-2.885390082f * u)); }
__device__ __forceinline__ float silu_f(float x) { return x * __builtin_amdgcn_rcpf(1.0f + __builtin_amdgcn_exp2f(-1.442695041f * x)); }
__device__ __forceinline__ float exp_f(float x) { return __builtin_amdgcn_exp2f(1.442695041f * x); }
__device__ __forceinline__ float softplus_f(float x) { return x > 20.f ? x : log1pf(__expf(x)); }
__device__ __forceinline__ void unpack8(const u32x4 w, float (&f)[8]) { f[0] = lo2f(w.x); f[1] = hi2f(w.x); f[2] = lo2f(w.y); f[3] = hi2f(w.y); f[4] = lo2f(w.z); f[5] = hi2f(w.z); f[6] = lo2f(w.w); f[7] = hi2f(w.w); }

struct EpiIn {
  static constexpr bool PERM = true, AFTER_DRAIN = false;
  bf16_t *UG, *VG, *Z, *XBC; float* DT;
  __device__ __forceinline__ void operator()(const f32x4 (&acc)[2][2][4][2], const Unit& u, int wr, int wc, int fr, int fq) const {
    const int row0 = u.pm * 256 + wr * 64 + fr; const int pn = u.pn;
    if (pn < 18) {
      bf16_t* base; int ld, colt;
      if (pn < 4) { base = UG; ld = 1024; colt = pn * 256; } else if (pn < 8) { base = VG; ld = 1024; colt = (pn - 4) * 256; }
      else if (pn < 12) { base = Z; ld = 1024; colt = (pn - 8) * 256; } else { base = XBC; ld = XW; colt = (pn - 12) * 256; }
      const int col0 = colt + wc * 32 + 8 * fq; const bool act = pn < 8;
#pragma unroll
      for (int ai = 0; ai < 2; ++ai)
#pragma unroll
        for (int m = 0; m < 4; ++m) { bf16_t* rowp = base + (size_t)(row0 + ai * 128 + m * 16) * ld + col0;
#pragma unroll
          for (int bj = 0; bj < 2; ++bj) { f32x4 v0 = acc[ai][bj][m][0], v1 = acc[ai][bj][m][1];
            if (act) {
#pragma unroll
              for (int j = 0; j < 4; ++j) { v0[j] = gelu_t(v0[j]); v1[j] = gelu_t(v1[j]); } }
            u32x4 w; w.x = cvt_pk_bf16(v0[0], v0[1]); w.y = cvt_pk_bf16(v0[2], v0[3]); w.z = cvt_pk_bf16(v1[0], v1[1]); w.w = cvt_pk_bf16(v1[2], v1[3]);
            *(u32x4*)(rowp + bj * 128) = w; } }
    } else if (wc == 0 && fq < 2) {
#pragma unroll
      for (int ai = 0; ai < 2; ++ai)
#pragma unroll
        for (int m = 0; m < 4; ++m) { float* p = DT + (size_t)(row0 + ai * 128 + m * 16) * 16 + 8 * fq; *(f32x4*)p = acc[ai][0][m][0]; *(f32x4*)(p + 4) = acc[ai][0][m][1]; }
    }
  }
};
struct EpiRes {
  static constexpr bool PERM = false, AFTER_DRAIN = false;
  float* X;
  __device__ __forceinline__ void operator()(const f32x4 (&acc)[2][2][4][2], const Unit& u, int wr, int wc, int fr, int fq) const {
    const int row0 = u.pm * 256 + wr * 64 + fr, col0 = u.pn * 256 + wc * 32 + 4 * fq;
#pragma unroll
    for (int ai = 0; ai < 2; ++ai)
#pragma unroll
      for (int m = 0; m < 4; ++m) { const int row = row0 + ai * 128 + m * 16;
        if (row < T) { float* rowp = X + (size_t)row * 1024 + col0;
#pragma unroll
          for (int bj = 0; bj < 2; ++bj)
#pragma unroll
            for (int n = 0; n < 2; ++n) { f32x4 x = *(const f32x4*)(rowp + bj * 128 + n * 16); *(f32x4*)(rowp + bj * 128 + n * 16) = x * ALPHA + acc[ai][bj][m][n]; } } }
  }
};
struct EpiRelu2 {
  static constexpr bool PERM = true, AFTER_DRAIN = false;
  bf16_t* H;
  __device__ __forceinline__ void operator()(const f32x4 (&acc)[2][2][4][2], const Unit& u, int wr, int wc, int fr, int fq) const {
    const int row0 = u.pm * 256 + wr * 64 + fr, col0 = u.pn * 256 + wc * 32 + 8 * fq;
#pragma unroll
    for (int ai = 0; ai < 2; ++ai)
#pragma unroll
      for (int m = 0; m < 4; ++m) { bf16_t* rowp = H + (size_t)(row0 + ai * 128 + m * 16) * DFF + col0;
#pragma unroll
        for (int bj = 0; bj < 2; ++bj) { f32x4 v0 = acc[ai][bj][m][0], v1 = acc[ai][bj][m][1];
#pragma unroll
          for (int j = 0; j < 4; ++j) { const float a = fmaxf(v0[j], 0.f), b = fmaxf(v1[j], 0.f); v0[j] = a * a; v1[j] = b * b; }
          u32x4 w; w.x = cvt_pk_bf16(v0[0], v0[1]); w.y = cvt_pk_bf16(v0[2], v0[3]); w.z = cvt_pk_bf16(v1[0], v1[1]); w.w = cvt_pk_bf16(v1[2], v1[3]);
          *(u32x4*)(rowp + bj * 128) = w; } }
  }
};

__device__ __forceinline__ void cvt_tile(LAS unsigned char* lds, const float* __restrict__ W, bf16_t* __restrict__ Wt, int K, int N, int ntn, int tile) {
  LAS float* t = (LAS float*)lds; int tid_ = threadIdx.x; asm volatile("" : "+v"(tid_)); const int tid = tid_; const int kt = tile / ntn, nt = tile - kt * ntn; const int k0 = kt * 64, n0 = nt * 64;
#pragma unroll
  for (int it = 0; it < 2; ++it) { const int kk = (tid >> 4) + it * 32, nn = (tid & 15) * 4; f32x4 v = {0.f, 0.f, 0.f, 0.f};
    if (n0 + nn < N) v = *(const f32x4*)(W + (size_t)(k0 + kk) * N + n0 + nn);
    t[kk * 65 + nn] = v[0]; t[kk * 65 + nn + 1] = v[1]; t[kk * 65 + nn + 2] = v[2]; t[kk * 65 + nn + 3] = v[3]; }
  __syncthreads();
  { const int nn = tid >> 3, kk = (tid & 7) * 8; float f[8];
#pragma unroll
    for (int i = 0; i < 8; ++i) f[i] = t[(kk + i) * 65 + nn];
    u32x4 w; w.x = cvt_pk_bf16(f[0], f[1]); w.y = cvt_pk_bf16(f[2], f[3]); w.z = cvt_pk_bf16(f[4], f[5]); w.w = cvt_pk_bf16(f[6], f[7]);
    *(u32x4*)(Wt + (size_t)(n0 + nn) * K + k0 + kk) = w; }
  __syncthreads();
}

constexpr int PT = 136;
__device__ __forceinline__ void gmlp_item(LAS unsigned char* lds, const Lp& p, int l, int rowbase, int nrows, int h, float* vout  ) {
  int tid_ = threadIdx.x; asm volatile("" : "+v"(tid_)); const int tid = tid_, wid = __builtin_amdgcn_readfirstlane(tid >> 6), lane = tid & 63, fr = lane & 15, fq = lane >> 4;
  const bf16_t* VG = (const bf16_t*)(p.ws + WS_VG); const bf16_t* UG = (const bf16_t*)(p.ws + WS_UG); bf16_t* MIX = (bf16_t*)(p.ws + WS_MIX);
  const bf16_t* GW = (const bf16_t*)(p.ws + WS_GW) + (size_t)(l * 8 + h) * 128 * 128;
  LAS bf16_t* vT = (LAS bf16_t*)lds; LAS f32x2* st = (LAS f32x2*)(lds + 128 * PT * 2);
  for (int rr = 0; rr < 16; ++rr) { const int row = wid * 16 + rr; float mean = 0.f, rstd = 0.f;
    if (row < nrows) { const u32x4* src = (const u32x4*)(VG + (size_t)(rowbase + row) * 1024 + lane * 16); float f[16]; { float a[8], b[8]; unpack8(src[0], a); unpack8(src[1], b);
#pragma unroll
        for (int i = 0; i < 8; ++i) { f[i] = a[i]; f[8 + i] = b[i]; } }
      float s = 0.f;
#pragma unroll
      for (int i = 0; i < 16; ++i) s += f[i];
#pragma unroll
      for (int o = 32; o >= 1; o >>= 1) s += __shfl_xor(s, o);
      mean = s * (1.0f / 1024.0f); float q = 0.f;
#pragma unroll
      for (int i = 0; i < 16; ++i) { const float d = f[i] - mean; q += d * d; }
#pragma unroll
      for (int o = 32; o >= 1; o >>= 1) q += __shfl_xor(q, o);
      rstd = rsqrtf(q * (1.0f / 1024.0f) + LN_EPS); }
    if (lane == 0) st[row] = (f32x2){mean, rstd}; }
  __syncthreads();
  { const int s = tid >> 2, cg0 = (tid & 3) * 32; const f32x2 ms = st[s]; const float* G = p.in[5] + l * 1024 + h * 128 + cg0; const float* Bb = p.in[6] + l * 1024 + h * 128 + cg0;
#pragma unroll
    for (int i = 0; i < 4; ++i) { float f[8];
      if (s < nrows) { unpack8(*(const u32x4*)(VG + (size_t)(rowbase + s) * 1024 + h * 128 + cg0 + 8 * i), f);
#pragma unroll
        for (int e = 0; e < 8; ++e) f[e] = (f[e] - ms.x) * ms.y * G[8 * i + e] + Bb[8 * i + e];
        if (vout) { float* o = vout + (size_t)s * 1024 + h * 128 + cg0 + 8 * i; *(f32x4*)o = (f32x4){f[0], f[1], f[2], f[3]}; *(f32x4*)(o + 4) = (f32x4){f[4], f[5], f[6], f[7]}; }
      } else {
#pragma unroll
        for (int e = 0; e < 8; ++e) f[e] = 0.f; }
#pragma unroll
      for (int e = 0; e < 8; ++e) vT[(cg0 + 8 * i + e) * PT + s] = f2bf(f[e]); } }
  __syncthreads();
  if (wid * 16 < nrows) {
    f32x4 acc[8];
#pragma unroll
    for (int n = 0; n < 8; ++n) acc[n] = (f32x4){0.f, 0.f, 0.f, 0.f};
    const int nks = (wid * 16 + 15) / 32 + 1;
    for (int ks = 0; ks < nks; ++ks) { const bf16x8 a = *(const bf16x8*)(GW + (size_t)(wid * 16 + fr) * 128 + ks * 32 + fq * 8);
#pragma unroll
      for (int n = 0; n < 8; ++n) { const bf16x8 b = *(const LAS bf16x8*)(vT + (n * 16 + fr) * PT + ks * 32 + fq * 8); acc[n] = __builtin_amdgcn_mfma_f32_16x16x32_bf16(b, a, acc[n], 0, 0, 0); } }
    const int t = wid * 16 + fr;
    if (t < nrows) { const float bs = p.in[8][(l * 8 + h) * 128 + t]; const size_t row = (size_t)(rowbase + t);
#pragma unroll
      for (int n = 0; n < 8; ++n) { const int col = h * 128 + n * 16 + fq * 4; const u32x2 ug = *(const u32x2*)(UG + row * 1024 + col);
        u32x2 w; w.x = cvt_pk_bf16(lo2f(ug.x) * (acc[n][0] + bs), hi2f(ug.x) * (acc[n][1] + bs)); w.y = cvt_pk_bf16(lo2f(ug.y) * (acc[n][2] + bs), hi2f(ug.y) * (acc[n][3] + bs));
        *(u32x2*)(MIX + row * MIXW + col) = w; } } }
  __syncthreads();
}
constexpr int L_CM = 0, L_BM = 128 * PT * 2, L_BST = 2 * 128 * PT * 2, L_XT = 3 * 128 * PT * 2, L_HB = L_XT + 64 * PT * 2, L_AC = L_HB + 64 * PT * 2, L_DT = L_AC + 512;
static_assert(L_DT + 512 <= LDS_BYTES, "LDS");
__device__ __forceinline__ void ssd_item(LAS unsigned char* lds, const Lp& p, int l, int b, int h, bool sample) {
  int tid_ = threadIdx.x; asm volatile("" : "+v"(tid_)); const int tid = tid_, wid = __builtin_amdgcn_readfirstlane(tid >> 6), lane = tid & 63, fr = lane & 15, fq = lane >> 4;
  const int rowbase = sample ? TPR + b * DSEQ : b * SEQ, nchunk = sample ? 1 : SEQ / 128, nrows = sample ? DSEQ : 128, g = h >> 3;
  const bf16_t* XBC = (const bf16_t*)(p.ws + WS_XBC); const bf16_t* Z = (const bf16_t*)(p.ws + WS_Z); const float* DT = (const float*)(p.ws + WS_DT);
  bf16_t* MIX = (bf16_t*)(p.ws + WS_MIX); float* SS = (float*)(p.ws + WS_SS);
  LAS bf16_t* Cm = (LAS bf16_t*)(lds + L_CM); LAS bf16_t* Bm = (LAS bf16_t*)(lds + L_BM); LAS bf16_t* BsT = (LAS bf16_t*)(lds + L_BST);
  LAS bf16_t* xT = (LAS bf16_t*)(lds + L_XT); LAS bf16_t* hb = (LAS bf16_t*)(lds + L_HB); LAS float* acum = (LAS float*)(lds + L_AC); LAS float* dtv = (LAS float*)(lds + L_DT);
  const float av = -__expf(p.in[12][l * 16 + h]), dtb = p.in[11][l * 16 + h], Dh = p.in[13][l * 16 + h];
  const float* convw = p.in[9] + (size_t)l * 4 * XW; const float* convb = p.in[10] + (size_t)l * XW;
  const float* cstate = p.in[3] + (size_t)(l * 8 + b) * 3 * XW;
  f32x4 hacc[4];
#pragma unroll
  for (int pt = 0; pt < 4; ++pt) { hacc[pt] = (f32x4){0.f, 0.f, 0.f, 0.f};
    if (sample) hacc[pt] = *(const f32x4*)(p.in[2] + ((size_t)((l * 8 + b) * 16 + h) * 64 + pt * 16 + fr) * 128 + wid * 16 + fq * 4);
    u32x2 w; w.x = cvt_pk_bf16(hacc[pt][0], hacc[pt][1]); w.y = cvt_pk_bf16(hacc[pt][2], hacc[pt][3]); *(LAS u32x2*)(hb + (pt * 16 + fr) * PT + wid * 16 + fq * 4) = w; }
  for (int c = 0; c < nchunk; ++c) {
    const int crow = rowbase + c * 128;
    if (wid < 2) { const int j = tid; float dt = 0.f; if (j < nrows) dt = softplus_f(DT[(size_t)(crow + j) * 16 + h] + dtb);
      float s = dt * av;
#pragma unroll
      for (int o = 1; o < 64; o <<= 1) { const float t = __shfl_up(s, o); if (lane >= o) s += t; }
      if (wid == 1) { float d0 = 0.f; if (lane < nrows) d0 = softplus_f(DT[(size_t)(crow + lane) * 16 + h] + dtb); float t0 = d0 * av;
#pragma unroll
        for (int o = 32; o >= 1; o >>= 1) t0 += __shfl_xor(t0, o);
        s += t0; }
      acum[j] = s; dtv[j] = dt; }
    __syncthreads();
    const float alast = acum[127];
    for (int task = tid; task < 640; task += 512) { const int cgi = task % 40, rr = task / 40; int ch, kind, nn;
      if (cgi < 8) { kind = 0; nn = cgi * 8; ch = h * 64 + nn; } else if (cgi < 24) { kind = 1; nn = (cgi - 8) * 8; ch = 1024 + g * 128 + nn; } else { kind = 2; nn = (cgi - 24) * 8; ch = 1280 + g * 128 + nn; }
      float w0[8], w1[8], w2[8], w3[8], bb[8], p0[8], p1[8], p2[8];
#pragma unroll
      for (int e = 0; e < 8; ++e) { w0[e] = convw[ch + e]; w1[e] = convw[XW + ch + e]; w2[e] = convw[2 * XW + ch + e]; w3[e] = convw[3 * XW + ch + e]; bb[e] = convb[ch + e]; }
      const int j0 = rr * 8;
#pragma unroll
      for (int i = 0; i < 3; ++i) { const int pos = c * 128 + j0 - 3 + i; float f[8];
        if (pos >= 0) unpack8(*(const u32x4*)(XBC + (size_t)(rowbase + pos) * XW + ch), f);
        else {
#pragma unroll
          for (int e = 0; e < 8; ++e) f[e] = sample ? cstate[(3 + pos) * XW + ch + e] : 0.f; }
#pragma unroll
        for (int e = 0; e < 8; ++e) { if (i == 0) p0[e] = f[e]; else if (i == 1) p1[e] = f[e]; else p2[e] = f[e]; } }
#pragma unroll
      for (int jj = 0; jj < 8; ++jj) { const int j = j0 + jj; float cur[8], o[8]; unpack8(*(const u32x4*)(XBC + (size_t)(crow + j) * XW + ch), cur);
#pragma unroll
        for (int e = 0; e < 8; ++e) { const float v = bb[e] + w0[e] * p0[e] + w1[e] * p1[e] + w2[e] * p2[e] + w3[e] * cur[e]; o[e] = (j < nrows) ? silu_f(v) : 0.f; p0[e] = p1[e]; p1[e] = p2[e]; p2[e] = cur[e]; }
        if (kind == 0) {
#pragma unroll
          for (int e = 0; e < 8; ++e) xT[(nn + e) * PT + j] = f2bf(o[e]);
        } else { u32x4 w; w.x = cvt_pk_bf16(o[0], o[1]); w.y = cvt_pk_bf16(o[2], o[3]); w.z = cvt_pk_bf16(o[4], o[5]); w.w = cvt_pk_bf16(o[6], o[7]);
          if (kind == 1) { *(LAS u32x4*)(Bm + j * PT + nn) = w; const float wj = exp_f(alast - acum[j]) * dtv[j];
#pragma unroll
            for (int e = 0; e < 8; ++e) BsT[(nn + e) * PT + j] = f2bf(o[e] * wj);
          } else *(LAS u32x4*)(Cm + j * PT + nn) = w; } } }
    __syncthreads();
    f32x4 cb[8];
#pragma unroll
    for (int jt = 0; jt < 8; ++jt) cb[jt] = (f32x4){0.f, 0.f, 0.f, 0.f};
#pragma unroll
    for (int ks = 0; ks < 4; ++ks) { const bf16x8 bq = *(const LAS bf16x8*)(Cm + (wid * 16 + fr) * PT + ks * 32 + fq * 8);
#pragma unroll
      for (int jt = 0; jt < 8; ++jt) if (jt <= wid) { const bf16x8 a = *(const LAS bf16x8*)(Bm + (jt * 16 + fr) * PT + ks * 32 + fq * 8); cb[jt] = __builtin_amdgcn_mfma_f32_16x16x32_bf16(a, bq, cb[jt], 0, 0, 0); } }
    __syncthreads();
    { const int i = wid * 16 + fr; const float ai = acum[i];
#pragma unroll
      for (int jt = 0; jt < 8; ++jt) { float v[4];
#pragma unroll
        for (int r = 0; r < 4; ++r) { const int j = jt * 16 + fq * 4 + r; float x = 0.f; if (jt <= wid && j <= i) x = cb[jt][r] * exp_f(ai - acum[j]) * dtv[j]; if (j == i) x += Dh; v[r] = x; }
        u32x2 w; w.x = cvt_pk_bf16(v[0], v[1]); w.y = cvt_pk_bf16(v[2], v[3]); *(LAS u32x2*)(Bm + i * PT + jt * 16 + fq * 4) = w; } }
    __syncthreads();
    { f32x4 y[4];
#pragma unroll
      for (int pt = 0; pt < 4; ++pt) y[pt] = (f32x4){0.f, 0.f, 0.f, 0.f};
#pragma unroll
      for (int ks = 0; ks < 4; ++ks) { const bf16x8 bq = *(const LAS bf16x8*)(Cm + (wid * 16 + fr) * PT + ks * 32 + fq * 8);
#pragma unroll
        for (int pt = 0; pt < 4; ++pt) { const bf16x8 a = *(const LAS bf16x8*)(hb + (pt * 16 + fr) * PT + ks * 32 + fq * 8); y[pt] = __builtin_amdgcn_mfma_f32_16x16x32_bf16(a, bq, y[pt], 0, 0, 0); } }
      const int i = wid * 16 + fr; const float ei = exp_f(acum[i]);
#pragma unroll
      for (int pt = 0; pt < 4; ++pt) y[pt] *= ei;
      const int nks = (wid * 16 + 15) / 32 + 1;
      for (int ks = 0; ks < nks; ++ks) { const bf16x8 bq = *(const LAS bf16x8*)(Bm + (wid * 16 + fr) * PT + ks * 32 + fq * 8);
#pragma unroll
        for (int pt = 0; pt < 4; ++pt) { const bf16x8 a = *(const LAS bf16x8*)(xT + (pt * 16 + fr) * PT + ks * 32 + fq * 8); y[pt] = __builtin_amdgcn_mfma_f32_16x16x32_bf16(a, bq, y[pt], 0, 0, 0); } }
      float ss = 0.f; const size_t row = (size_t)(crow + i);
      if (i < nrows) {
#pragma unroll
        for (int pt = 0; pt < 4; ++pt) { const int col = h * 64 + pt * 16 + fq * 4; const u32x2 zz = *(const u32x2*)(Z + row * 1024 + col);
          const float h0 = y[pt][0] * silu_f(lo2f(zz.x)), h1 = y[pt][1] * silu_f(hi2f(zz.x)), h2 = y[pt][2] * silu_f(lo2f(zz.y)), h3 = y[pt][3] * silu_f(hi2f(zz.y));
          ss += (h0 * h0 + h1 * h1) + (h2 * h2 + h3 * h3);
          u32x2 w; w.x = cvt_pk_bf16(h0, h1); w.y = cvt_pk_bf16(h2, h3); *(u32x2*)(MIX + row * MIXW + 1024 + col) = w; } }
      ss += __shfl_xor(ss, 16); ss += __shfl_xor(ss, 32);
      if (fq == 0 && i < nrows) SS[row * 16 + h] = ss; }
    { const float el = exp_f(alast);
#pragma unroll
      for (int pt = 0; pt < 4; ++pt) hacc[pt] *= el;
#pragma unroll
      for (int ks = 0; ks < 4; ++ks) { const bf16x8 a = *(const LAS bf16x8*)(BsT + (wid * 16 + fr) * PT + ks * 32 + fq * 8);
#pragma unroll
        for (int pt = 0; pt < 4; ++pt) { const bf16x8 bq = *(const LAS bf16x8*)(xT + (pt * 16 + fr) * PT + ks * 32 + fq * 8); hacc[pt] = __builtin_amdgcn_mfma_f32_16x16x32_bf16(a, bq, hacc[pt], 0, 0, 0); } } }
    __syncthreads();
#pragma unroll
    for (int pt = 0; pt < 4; ++pt) { u32x2 w; w.x = cvt_pk_bf16(hacc[pt][0], hacc[pt][1]); w.y = cvt_pk_bf16(hacc[pt][2], hacc[pt][3]); *(LAS u32x2*)(hb + (pt * 16 + fr) * PT + wid * 16 + fq * 4) = w; }
  }
  { float* dst = p.out + (sample ? O_SSMS : O_SSMP) + ((size_t)((l * 8 + b) * 16 + h) * 64) * 128;
#pragma unroll
    for (int pt = 0; pt < 4; ++pt) *(f32x4*)(dst + (size_t)(pt * 16 + fr) * 128 + wid * 16 + fq * 4) = hacc[pt]; }
  __syncthreads();
}
__device__ __forceinline__ void ln_phase(const Lp& p, const float* __restrict__ g, const float* __restrict__ b) {
  const int tid = p.tid, wid = tid >> 6, lane = tid & 63; float* X = p.out; bf16_t* Xb = (bf16_t*)(p.ws + WS_XB);
  f32x4 gv[4], bv[4];
#pragma unroll
  for (int i = 0; i < 4; ++i) { gv[i] = *(const f32x4*)(g + i * 256 + lane * 4); bv[i] = *(const f32x4*)(b + i * 256 + lane * 4); }
  for (int row = p.bid * 8 + wid; row < T; row += p.G * 8) { f32x4 v[4]; float s = 0.f;
#pragma unroll
    for (int i = 0; i < 4; ++i) { v[i] = *(const f32x4*)(X + (size_t)row * 1024 + i * 256 + lane * 4); s += (v[i][0] + v[i][1]) + (v[i][2] + v[i][3]); }
#pragma unroll
    for (int o = 32; o >= 1; o >>= 1) s += __shfl_xor(s, o);
    const float mean = s * (1.0f / 1024.0f); float q = 0.f;
#pragma unroll
    for (int i = 0; i < 4; ++i) { const f32x4 d = v[i] - mean; q += (d[0] * d[0] + d[1] * d[1]) + (d[2] * d[2] + d[3] * d[3]); }
#pragma unroll
    for (int o = 32; o >= 1; o >>= 1) q += __shfl_xor(q, o);
    const float rstd = rsqrtf(q * (1.0f / 1024.0f) + LN_EPS);
#pragma unroll
    for (int i = 0; i < 4; ++i) { const f32x4 y = (v[i] - mean) * rstd * gv[i] + bv[i]; *(f32x4*)(X + (size_t)row * 1024 + i * 256 + lane * 4) = y;
      u32x2 w; w.x = cvt_pk_bf16(y[0], y[1]); w.y = cvt_pk_bf16(y[2], y[3]); *(u32x2*)(Xb + (size_t)row * 1024 + i * 256 + lane * 4) = w; } }
}
__device__ __forceinline__ void rms_phase(const Lp& p, int l) {
  const int tid = p.tid, wid = tid >> 6, lane = tid & 63; bf16_t* MIX = (bf16_t*)(p.ws + WS_MIX); const float* SS = (const float*)(p.ws + WS_SS);
  const float* gm = p.in[14] + l * 1024 + lane * 16; float gv[16];
#pragma unroll
  for (int i = 0; i < 16; ++i) gv[i] = gm[i];
  for (int row = p.bid * 8 + wid; row < T; row += p.G * 8) {
    const f32x4 s0 = *(const f32x4*)(SS + (size_t)row * 16 + (lane >> 5) * 8), s1 = *(const f32x4*)(SS + (size_t)row * 16 + (lane >> 5) * 8 + 4);
    const float ssum = ((s0[0] + s0[1]) + (s0[2] + s0[3])) + ((s1[0] + s1[1]) + (s1[2] + s1[3])); const float rstd = rsqrtf(ssum * (1.0f / 512.0f) + RMS_EPS);
    u32x4* ptr = (u32x4*)(MIX + (size_t)row * MIXW + 1024 + lane * 16);
#pragma unroll
    for (int k = 0; k < 2; ++k) { float f[8]; unpack8(ptr[k], f);
#pragma unroll
      for (int e = 0; e < 8; ++e) f[e] *= rstd * gv[k * 8 + e];
      u32x4 w; w.x = cvt_pk_bf16(f[0], f[1]); w.y = cvt_pk_bf16(f[2], f[3]); w.z = cvt_pk_bf16(f[4], f[5]); w.w = cvt_pk_bf16(f[6], f[7]); ptr[k] = w; } }
}

constexpr int NPH = 1 + 8 * DEPTH;
__device__ __forceinline__ void p0_phase(LAS unsigned char* lds, const Lp& p) {
  const int tid = p.tid, bid = p.bid, G = p.G; bf16_t* Xb = (bf16_t*)(p.ws + WS_XB); bf16_t* GW = (bf16_t*)(p.ws + WS_GW);
  for (size_t i = (size_t)bid * 512 + tid; i < (size_t)TP * 128; i += (size_t)G * 512) { const size_t e = i * 8; u32x4 w = {0u, 0u, 0u, 0u};
    if (e < (size_t)T * 1024) { const float* src = e < (size_t)TPR * 1024 ? p.in[0] + e : p.in[1] + (e - (size_t)TPR * 1024); const f32x4 a = *(const f32x4*)src, b = *(const f32x4*)(src + 4);
      *(f32x4*)(p.out + e) = a; *(f32x4*)(p.out + e + 4) = b; w.x = cvt_pk_bf16(a[0], a[1]); w.y = cvt_pk_bf16(a[2], a[3]); w.z = cvt_pk_bf16(b[0], b[1]); w.w = cvt_pk_bf16(b[2], b[3]); }
    *(u32x4*)(Xb + e) = w; }
  for (int i = bid * 512 + tid; i < DEPTH * 8 * 128 * 128; i += G * 512) { const int s = i & 127, t = (i >> 7) & 127; GW[i] = s <= t ? f2bf(p.in[7][i]) : (bf16_t)0; }
  for (int t = bid; t < 16 * (NINP / 64); t += G) cvt_tile(lds, p.in[4], (bf16_t*)(p.ws + WS_WIN), 1024, NIN, NINP / 64, t);
}
__device__ __forceinline__ void mixer_phase(LAS unsigned char* lds, const Lp& p, int l) {
  const int tid = p.tid, bid = p.bid, G = p.G; const bf16_t* XBC = (const bf16_t*)(p.ws + WS_XBC);
  for (int i = bid * 512 + tid; i < 2 * 8 * 3 * XW; i += G * 512) { const int smp = i / (8 * 3 * XW), r = i - smp * (8 * 3 * XW), b = r / (3 * XW), k = (r / XW) % 3, ch = r % XW;
    const size_t row = smp ? (size_t)(TPR + b * DSEQ + DSEQ - 3 + k) : (size_t)(b * SEQ + SEQ - 3 + k);
    p.out[(smp ? O_CONVS : O_CONVP) + (size_t)l * 8 * 3 * XW + r] = bf2f(XBC[row * XW + ch]); }
  const int nS = G >= 256 ? 128 : (G + 1) / 2;
  if (bid < nS) {
    for (int it = bid; it < 256; it += nS) ssd_item(lds, p, l, (it & 127) >> 4, it & 15, it >= 128);
  } else {
    const int j = bid - nS, nw = G - nS;
    for (int it = j; it < 1024 + 64; it += nw) { const bool smp = it >= 1024; const int i2 = it - 1024;
      gmlp_item(lds, p, l, smp ? TPR + (i2 >> 3) * DSEQ : (it >> 7) * SEQ + ((it >> 3) & 15) * 128, smp ? DSEQ : 128, it & 7, smp ? p.out + O_VS + (size_t)((l * 8 + (i2 >> 3)) * DSEQ) * 1024 : nullptr); }
    const int n1 = 512, n2 = 1024, n3 = 1024, n4 = (l + 1 < DEPTH) ? 16 * (NINP / 64) : 0;
    for (int t = j; t < n1 + n2 + n3 + n4; t += nw) { const float* W; bf16_t* Wt; int K, N, ntn, tt;
      if (t < n1) { W = p.in[15] + (size_t)l * 2048 * 1024; Wt = (bf16_t*)(p.ws + WS_WOUT); K = 2048; N = 1024; ntn = 16; tt = t; }
      else if (t < n1 + n2) { W = p.in[18] + (size_t)l * 1024 * 4096; Wt = (bf16_t*)(p.ws + WS_WF1); K = 1024; N = 4096; ntn = 64; tt = t - n1; }
      else if (t < n1 + n2 + n3) { W = p.in[19] + (size_t)l * 4096 * 1024; Wt = (bf16_t*)(p.ws + WS_WF2); K = 4096; N = 1024; ntn = 16; tt = t - n1 - n2; }
      else { W = p.in[4] + (size_t)(l + 1) * 1024 * NIN; Wt = (bf16_t*)(p.ws + WS_WIN); K = 1024; N = NIN; ntn = NINP / 64; tt = t - n1 - n2 - n3; }
      cvt_tile(lds, W, Wt, K, N, ntn, tt); }
  }
}
__global__ void __launch_bounds__(512, 2) mk_fwd(Params pa) {
  extern __shared__ __attribute__((aligned(16))) unsigned char shm[];
  LAS unsigned char* lds = (LAS unsigned char*)shm;
  for (int ph = pa.ph_lo; ph < pa.ph_hi; ++ph) {
    int z; asm volatile("s_mov_b32 %0, 0" : "=s"(z));
    const Lp p{InProxy{pa, z}, pa.ws + z, pa.out + z, (int)threadIdx.x + z, (int)blockIdx.x + z, (int)gridDim.x + z};
    const int l = (ph - 1) >> 3, k = (ph - 1) & 7;
    if (ph == 0) p0_phase(lds, p);
    else if (k == 0) {
      pg8::Gemm g{(const bf16_t*)(p.ws + WS_XB), (const bf16_t*)(p.ws + WS_WIN), TP, NINP, 1024}; pg8::StaticOrder S; S.init(TP, NINP, p.G, p.bid);
      EpiIn E{(bf16_t*)(p.ws + WS_UG), (bf16_t*)(p.ws + WS_VG), (bf16_t*)(p.ws + WS_Z), (bf16_t*)(p.ws + WS_XBC), (float*)(p.ws + WS_DT)};
      pg8::gemm_phase<EpiIn, pg8::StaticOrder, false>(lds, g, S, E, nullptr);
    } else if (k == 1) mixer_phase(lds, p, l);
    else if (k == 2) rms_phase(p, l);
    else if (k == 3 || k == 6) {
      pg8::Gemm g{(const bf16_t*)(p.ws + (k == 3 ? WS_MIX : WS_H)), (const bf16_t*)(p.ws + (k == 3 ? WS_WOUT : WS_WF2)), TP, 1024, k == 3 ? MIXW : DFF}; pg8::StaticOrder S; S.init(TP, 1024, p.G, p.bid);
      EpiRes E{p.out};
      pg8::gemm_phase<EpiRes, pg8::StaticOrder, false>(lds, g, S, E, nullptr);
    } else if (k == 5) {
      pg8::Gemm g{(const bf16_t*)(p.ws + WS_XB), (const bf16_t*)(p.ws + WS_WF1), TP, DFF, 1024}; pg8::StaticOrder S; S.init(TP, DFF, p.G, p.bid);
      EpiRelu2 E{(bf16_t*)(p.ws + WS_H)};
      pg8::gemm_phase<EpiRelu2, pg8::StaticOrder, false>(lds, g, S, E, nullptr);
    } else ln_phase(p, p.in[k == 4 ? 16 : 20] + l * 1024, p.in[k == 4 ? 17 : 21] + l * 1024);
    if (ph + 1 < pa.ph_hi) cg::this_grid().sync();
  }
}

extern "C" void kernel_launch(void* const* d_in, const int* in_sizes, int n_in, void* d_out, int out_size, void* d_ws, size_t ws_size, hipStream_t stream) {
  static int grid = 0;
  if (grid == 0) {
    if (n_in != 22 || ws_size < WS_END) { fprintf(stderr, "kernel_launch: n_in %d ws %zu (need %zu)\n", n_in, ws_size, (size_t)WS_END); grid = -1; return; }
    int dev = 0, cus = 0, per_cu = 0;
    hipGetDevice(&dev); hipDeviceGetAttribute(&cus, hipDeviceAttributeMultiprocessorCount, dev);
    if (hipFuncSetAttribute((const void*)mk_fwd, hipFuncAttributeMaxDynamicSharedMemorySize, LDS_BYTES) != hipSuccess) { fprintf(stderr, "kernel_launch: hipFuncSetAttribute failed\n"); grid = -1; return; }
    if (hipOccupancyMaxActiveBlocksPerMultiprocessor(&per_cu, (const void*)mk_fwd, 512, LDS_BYTES) != hipSuccess || per_cu < 1) { fprintf(stderr, "kernel_launch: occupancy query gave %d\n", per_cu); per_cu = 1; }
    (void)hipGetLastError();
    grid = cus * per_cu;
  }
  if (grid < 0) return;
  Params p{};
  for (int i = 0; i < 22; ++i) p.in[i] = (const float*)d_in[i];
  p.out = (float*)d_out; p.ws = (unsigned char*)d_ws;
#if defined(MK_MULTI)
  for (int i = 0; i < NPH; ++i) { p.ph_lo = i; p.ph_hi = i + 1; hipLaunchKernelGGL(mk_fwd, dim3(grid), dim3(512), LDS_BYTES, stream, p); }
#else
  p.ph_lo = 0; p.ph_hi = NPH;
  void* args[] = {&p};
  hipError_t e = hipLaunchCooperativeKernel((const void*)mk_fwd, dim3(grid), dim3(512), args, LDS_BYTES, stream);
  if (e != hipSuccess) fprintf(stderr, "cooperative launch failed: %s (grid %d)\n", hipGetErrorString(e), grid);
#endif
}
```

```cpp
#include <hip/hip_runtime.h>
#include <hip/hip_cooperative_groups.h>
#include <cstdio>
namespace cg = cooperative_groups;
namespace pg8 {
#define PG8_LAS __attribute__((address_space(3)))
typedef unsigned short bf16_t;
typedef short bf16x8 __attribute__((ext_vector_type(8)));
typedef float f32x4 __attribute__((ext_vector_type(4)));
typedef unsigned u32x4 __attribute__((ext_vector_type(4)));
constexpr int BM = 256, BK = 64, HALF = 128, HTB = HALF * BK * 2  , STAGE_BYTES = 8 * HTB, NXCD = 8, WGM = 8;

__host__ __device__ __forceinline__ int lds_byte(int r, int c) { const int st = (r >> 4) * 2 + (c >> 5), rr = r & 15, cc = c & 31, ob = rr * 64 + cc * 2; return st * 1024 + (ob ^ (((ob >> 9) & 1) << 5)); }
__host__ __device__ __forceinline__ void stage_rc(int b, int& R, int& C) { const int st = b / 1024, sb = b % 1024, swz = sb ^ (((sb >> 9) & 1) << 5); R = (st >> 1) * 16 + swz / 64; C = (st & 1) * 32 + (swz % 64) / 2; }
__host__ __device__ __forceinline__ int perm32(int rho) { const int n = rho >> 4, i = rho & 15; return 8 * (i >> 2) + 4 * n + (i & 3); }

struct Unit { int pm, pn; };
struct Gemm { const bf16_t* A; const bf16_t* Bt; int M, N, K; };

struct StaticOrder {
    int nM, nN, nwg, G, c;
    __host__ __device__ void init(int M, int N, int G_, int c_) { nM = M / BM; nN = N / BM; nwg = nM * nN; G = G_; c = c_; }
    __host__ __device__ bool next(int i, Unit& u) const {
        const long L = (long)i * G + c; if (L >= nwg) return false;
        int wgid = (int)L; { const int q = nwg / NXCD, r = nwg % NXCD, xcd = wgid % NXCD, off = wgid / NXCD; wgid = (xcd < r ? xcd * (q + 1) : r * (q + 1) + (xcd - r) * q) + off; }
        const int nig = WGM * nN, gid = wgid / nig, fm = gid * WGM, gsz = (nM - fm) < WGM ? (nM - fm) : WGM;
        u.pm = fm + ((wgid % nig) % gsz); u.pn = (wgid % nig) / gsz; return true;
    }
    __device__ __forceinline__ void a_ready(const Unit&) const {}
    __device__ __forceinline__ void done(const Unit&) const {}
};
__device__ __forceinline__ unsigned cvt_pk_bf16(float lo, float hi) { unsigned r; asm volatile("v_cvt_pk_bf16_f32 %0, %1, %2" : "=v"(r) : "v"(lo), "v"(hi)); return r; }
template <class Epi, class Sched, bool STAMP = false>
__device__ __forceinline__ void gemm_phase(PG8_LAS unsigned char* lds, const Gemm g, const Sched& S, const Epi& E, unsigned long long* stamps) {
    int tid_ = threadIdx.x; asm volatile("" : "+v"(tid_)); const int tid = tid_, wid = __builtin_amdgcn_readfirstlane(tid >> 6), lane = tid & 63, wr = wid >> 2, wc = wid & 3, fr = lane & 15, fq = lane >> 4;
    const int K = g.K, nt = K / BK;
    int ts_lo = 0, ts_hi = 0, nts = 0; const unsigned long long rt_entry = STAMP ? (unsigned long long)wall_clock64() : 0ull;
#define PG8_STAMP() do { if (STAMP && wid == 0 && nts < 64) { const unsigned long long _c = (unsigned long long)clock64(); \
        ts_lo = (lane == nts) ? (int)(unsigned)_c : ts_lo; ts_hi = (lane == nts) ? (int)(unsigned)(_c >> 32) : ts_hi; ++nts; } } while (0)
    PG8_STAMP();
    unsigned voffA[2], voffB[2];
#pragma unroll
    for (int i = 0; i < 2; ++i) { int R, C; stage_rc(tid * 16 + i * 8192, R, C); const int Rb = Epi::PERM ? ((R & ~31) + perm32(R & 31)) : R;
        voffA[i] = (unsigned)(R * K + C) * 2u; voffB[i] = (unsigned)(Rb * K + C) * 2u; }
    const size_t kstep = (size_t)(BK * 2);
    const size_t hstep = (size_t)HALF * K * 2;
    const size_t tstep = 2 * hstep;
    const unsigned ldsw = (unsigned)wid * 1024u;
    const int aoff = lds_byte(wr * 64 + fr, fq * 8), boff = lds_byte(wc * 32 + fr, fq * 8);
#define PG8_SA(b, h) (((b) * 2 + (h)) * HTB)
#define PG8_SB(b, h) ((4 + (b) * 2 + (h)) * HTB)
#define PG8_STAGE(bufoff, gbase, voff) do { _Pragma("unroll") for (int _i = 0; _i < 2; ++_i) \
        __builtin_amdgcn_global_load_lds((const unsigned*)((const char*)(gbase) + (voff)[_i]), (PG8_LAS unsigned*)(lds + (bufoff) + ldsw + _i * 8192), 16, 0, 0); } while (0)
#define PG8_LDA(dst, b, h) do { _Pragma("unroll") for (int m = 0; m < 4; ++m) _Pragma("unroll") for (int k = 0; k < 2; ++k) dst[m][k] = *(const PG8_LAS bf16x8*)(lds + PG8_SA(b, h) + aoff + m * 2048 + k * 1024); } while (0)
#define PG8_LDB(dst, b, h) do { _Pragma("unroll") for (int n = 0; n < 2; ++n) _Pragma("unroll") for (int k = 0; k < 2; ++k) dst[n][k] = *(const PG8_LAS bf16x8*)(lds + PG8_SB(b, h) + boff + n * 2048 + k * 1024); } while (0)
#define PG8_MMA(ai, bj, At, Bt) do { __builtin_amdgcn_s_setprio(1); _Pragma("unroll") for (int m = 0; m < 4; ++m) _Pragma("unroll") for (int n = 0; n < 2; ++n) _Pragma("unroll") for (int k = 0; k < 2; ++k) \
        acc[ai][bj][m][n] = __builtin_amdgcn_mfma_f32_16x16x32_bf16(Bt[n][k], At[m][k], acc[ai][bj][m][n], 0, 0, 0); __builtin_amdgcn_s_setprio(0); } while (0)
#define PG8_WAIT_V(n) asm volatile("s_waitcnt vmcnt(" #n ")" ::: "memory")
#define PG8_WAIT_L(n) asm volatile("s_waitcnt lgkmcnt(" #n ")" ::: "memory")
#define PG8_BAR __builtin_amdgcn_s_barrier()
#define PG8_SCHED __builtin_amdgcn_sched_barrier(0)
    Unit cur, nxt; int ui = 0;
    if (!S.next(0, cur)) return;
    f32x4 acc[2][2][4][2];
#pragma unroll
    for (int a = 0; a < 2; ++a)
#pragma unroll
        for (int b = 0; b < 2; ++b)
#pragma unroll
            for (int m = 0; m < 4; ++m)
#pragma unroll
                for (int n = 0; n < 2; ++n) acc[a][b][m][n] = (f32x4){0.f, 0.f, 0.f, 0.f};
    bf16x8 At[4][2], B0[2][2], B1[2][2];
    const char* cA = (const char*)g.A + (size_t)cur.pm * tstep; const char* cB = (const char*)g.Bt + (size_t)cur.pn * tstep;
    S.a_ready(cur);
    PG8_STAGE(PG8_SB(0, 0), cB, voffB); PG8_STAGE(PG8_SA(0, 0), cA, voffA); PG8_STAGE(PG8_SB(0, 1), cB + hstep, voffB); PG8_STAGE(PG8_SA(0, 1), cA + hstep, voffA);
    if (wr == 1) PG8_BAR;
    PG8_WAIT_V(4); PG8_BAR;
    PG8_STAGE(PG8_SB(1, 0), cB + kstep, voffB); PG8_STAGE(PG8_SA(1, 0), cA + kstep, voffA); PG8_STAGE(PG8_SB(1, 1), cB + hstep + kstep, voffB);
    PG8_WAIT_V(6); PG8_BAR;
    PG8_STAMP();
    for (;;) {
        const bool has_next = S.next(ui + 1, nxt);
        const char* nA = has_next ? (const char*)g.A + (size_t)nxt.pm * tstep : cA; const char* nB = has_next ? (const char*)g.Bt + (size_t)nxt.pn * tstep : cB;
        for (int t = 0; t < nt; t += 2) {
            const bool last = (t == nt - 2);
            const char* a1 = cA + (size_t)(t + 1) * kstep;
            const char* a2 = last ? nA : cA + (size_t)(t + 2) * kstep; const char* b2 = last ? nB : cB + (size_t)(t + 2) * kstep;
            const char* a3 = a2 + kstep; const char* b3 = b2 + kstep;
            if (last && has_next) S.a_ready(nxt);
            PG8_LDB(B0, 0, 0); PG8_SCHED; PG8_LDA(At, 0, 0); PG8_STAGE(PG8_SA(1, 1), a1 + hstep, voffA);
            PG8_WAIT_L(8); PG8_BAR; PG8_WAIT_L(0); PG8_MMA(0, 0, At, B0); PG8_BAR; PG8_SCHED;
            PG8_LDB(B1, 0, 1); PG8_STAGE(PG8_SB(0, 0), b2, voffB);
            PG8_BAR; PG8_WAIT_L(0); PG8_MMA(0, 1, At, B1); PG8_BAR;
            PG8_LDA(At, 0, 1); PG8_STAGE(PG8_SA(0, 0), a2, voffA);
            PG8_BAR; PG8_WAIT_L(0); PG8_MMA(1, 0, At, B0); PG8_BAR; PG8_SCHED;
            PG8_STAGE(PG8_SB(0, 1), b2 + hstep, voffB);
            PG8_WAIT_V(6); PG8_BAR; PG8_MMA(1, 1, At, B1); PG8_BAR;
            PG8_LDB(B0, 1, 0); PG8_SCHED; PG8_LDA(At, 1, 0); PG8_STAGE(PG8_SA(0, 1), a2 + hstep, voffA);
            PG8_WAIT_L(8); PG8_BAR; PG8_WAIT_L(0); PG8_MMA(0, 0, At, B0); PG8_BAR; PG8_SCHED;
            PG8_LDB(B1, 1, 1); PG8_STAGE(PG8_SB(1, 0), b3, voffB);
            PG8_BAR; PG8_WAIT_L(0); PG8_MMA(0, 1, At, B1); PG8_BAR;
            PG8_LDA(At, 1, 1); PG8_STAGE(PG8_SA(1, 0), a3, voffA);
            PG8_BAR; PG8_WAIT_L(0); PG8_MMA(1, 0, At, B0); PG8_BAR; PG8_SCHED;
            PG8_STAGE(PG8_SB(1, 1), b3 + hstep, voffB);
            PG8_WAIT_V(6); PG8_BAR; PG8_MMA(1, 1, At, B1); PG8_BAR;
        }
        PG8_STAMP();
        if constexpr (!Epi::AFTER_DRAIN) { E(acc, cur, wr, wc, fr, fq); S.done(cur); }
        PG8_STAMP();
        if (!has_next) break;
#pragma unroll
        for (int a = 0; a < 2; ++a)
#pragma unroll
            for (int b = 0; b < 2; ++b)
#pragma unroll
                for (int m = 0; m < 4; ++m)
#pragma unroll
                    for (int n = 0; n < 2; ++n) acc[a][b][m][n] = (f32x4){0.f, 0.f, 0.f, 0.f};
        cur = nxt; cA = nA; cB = nB; ++ui;
    }
    PG8_WAIT_V(0);
    if (wr == 0) PG8_BAR;
    PG8_BAR;
    if constexpr (Epi::AFTER_DRAIN) { E.fused(acc, cur, wr, wc, fr, fq, lds, wid, lane); S.done(cur); }
    PG8_STAMP();
    if (STAMP && wid == 0) { stamps[lane] = lane < nts ? (((unsigned long long)(unsigned)ts_hi << 32) | (unsigned)ts_lo) : 0ull;
        if (lane == 62) stamps[62] = rt_entry; if (lane == 63) stamps[63] = (unsigned long long)wall_clock64(); }
#undef PG8_STAMP
#undef PG8_SA
#undef PG8_SB
#undef PG8_STAGE
#undef PG8_LDA
#undef PG8_LDB
#undef PG8_MMA
#undef PG8_WAIT_V
#undef PG8_WAIT_L
#undef PG8_BAR
#undef PG8_SCHED
}
}
using pg8::bf16_t; using pg8::bf16x8; using pg8::f32x4; using pg8::u32x4; using pg8::cvt_pk_bf16; using pg8::Unit;
#define LAS __attribute__((address_space(3)))
typedef unsigned u32x2 __attribute__((ext_vector_type(2)));
typedef float f32x2 __attribute__((ext_vector_type(2)));

constexpr int DM = 1024, NB = 8, SEQ = 2048, DEPTH = 4, DSEQ = 16;
constexpr int TPR = NB * SEQ, T = TPR + NB * DSEQ, TP = 16640;
constexpr int NIN = 4624, NINP = 4864, XW = 1536, DFF = 4096, MIXW = 2048;
constexpr float ALPHA = 1.6817928305074290f;
constexpr float LN_EPS = 1e-5f, RMS_EPS = 1e-5f;
constexpr size_t SZ_ACT = (size_t)TP * 1024 * 2;
constexpr size_t WS_XB = 0;
constexpr size_t WS_YD = WS_XB;
constexpr size_t WS_UG = WS_XB + SZ_ACT, WS_VG = WS_UG + SZ_ACT, WS_Z = WS_VG + SZ_ACT, WS_XBC = WS_Z + SZ_ACT;
constexpr size_t WS_H = WS_UG;
constexpr size_t WS_MIX = WS_XBC + (size_t)TP * XW * 2;
constexpr size_t WS_DT = WS_MIX + (size_t)TP * MIXW * 2;
constexpr size_t WS_ACUM = WS_DT + (size_t)TP * 16 * 4;
constexpr size_t WS_VST = WS_ACUM + (size_t)TP * 16 * 4;
constexpr size_t WS_CN = WS_VST + (size_t)TP * 16 * 8;
constexpr int NST = 2048 + 128;
constexpr size_t WS_ST = WS_CN + (size_t)TP * 256 * 2;
constexpr size_t WS_DEC = WS_ST + (size_t)NST * 8192 * 2;
constexpr size_t WS_WOUT = WS_DEC + 16384;
constexpr size_t WS_WF1 = WS_WOUT + (size_t)1024 * 2048 * 2;
constexpr size_t WS_WIN = WS_WF1;
constexpr size_t WS_WF2 = WS_WF1 + (size_t)NINP * 1024 * 2;
constexpr size_t WS_GW = WS_WF2 + (size_t)4096 * 1024 * 2;
constexpr size_t WS_END = WS_GW + (size_t)DEPTH * 8 * 128 * 128 * 2;
static_assert(WS_XBC + (size_t)TP * XW * 2 - WS_UG >= (size_t)TP * DFF * 2, "H alias");
static_assert(WS_END <= (size_t)330883840, "workspace");
constexpr size_t O_YP = 0, O_YS = 16777216, O_SSMP = 16908288, O_CONVP = 21102592, O_SSMS = 21250048, O_CONVS = 25444352, O_VS = 25591808;
constexpr int LDS_BYTES = 135168;

struct Params {
  const float* in[22]; float* out; unsigned char* ws; int ph_lo, ph_hi;
};
struct InProxy { const Params& p; int z; __device__ __forceinline__ const float* operator[](int k) const { return p.in[k + z]; } };
struct Lp { InProxy in; unsigned char* ws; float* out; int tid, bid, G; };

__device__ __forceinline__ float bf2f(unsigned short b) { return __uint_as_float(((unsigned)b) << 16); }
__device__ __forceinline__ float lo2f(unsigned w) { return __uint_as_float(w << 16); }
__device__ __forceinline__ float hi2f(unsigned w) { return __uint_as_float(w & 0xffff0000u); }
__device__ __forceinline__ unsigned short f2bf(float f) { return (unsigned short)(cvt_pk_bf16(f, 0.f) & 0xffffu); }
__device__ __forceinline__ float gelu_t(float x) { const float u = 0.7978845608f * (x + 0.044715f * x * x * x); return x * __builtin_amdgcn_rcpf(1.0f + __builtin_amdgcn_exp2f(-2.885390082f * u)); }
__device__ __forceinline__ float silu_f(float x) { return x * __builtin_amdgcn_rcpf(1.0f + __builtin_amdgcn_exp2f(-1.442695041f * x)); }
__device__ __forceinline__ float exp_f(float x) { return __builtin_amdgcn_exp2f(1.442695041f * x); }
__device__ __forceinline__ float softplus_f(float x) { return x > 20.f ? x : log1pf(__expf(x)); }
__device__ __forceinline__ void unpack8(const u32x4 w, float (&f)[8]) { f[0] = lo2f(w.x); f[1] = hi2f(w.x); f[2] = lo2f(w.y); f[3] = hi2f(w.y); f[4] = lo2f(w.z); f[5] = hi2f(w.z); f[6] = lo2f(w.w); f[7] = hi2f(w.w); }

struct EpiIn {
  static constexpr bool PERM = true, AFTER_DRAIN = false;
  bf16_t *UG, *VG, *Z, *XBC; float* DT; f32x2* VST;
  __device__ __forceinline__ void operator()(const f32x4 (&acc)[2][2][4][2], const Unit& u, int wr, int wc, int fr, int fq) const {
    const int row0 = u.pm * 256 + wr * 64 + fr; const int pn = u.pn;
    if (pn < 18) {
      bf16_t* base; int ld, colt;
      if (pn < 4) { base = UG; ld = 1024; colt = pn * 256; } else if (pn < 8) { base = VG; ld = 1024; colt = (pn - 4) * 256; }
      else if (pn < 12) { base = Z; ld = 1024; colt = (pn - 8) * 256; } else { base = XBC; ld = XW; colt = (pn - 12) * 256; }
      const int col0 = colt + wc * 32 + 8 * fq; const bool act = pn < 8;
#pragma unroll
      for (int ai = 0; ai < 2; ++ai)
#pragma unroll
        for (int m = 0; m < 4; ++m) { bf16_t* rowp = base + (size_t)(row0 + ai * 128 + m * 16) * ld + col0; float rs = 0.f, rq = 0.f;
#pragma unroll
          for (int bj = 0; bj < 2; ++bj) { f32x4 v0 = acc[ai][bj][m][0], v1 = acc[ai][bj][m][1];
            if (act) {
#pragma unroll
              for (int j = 0; j < 4; ++j) { v0[j] = gelu_t(v0[j]); v1[j] = gelu_t(v1[j]); } }
            if (act) {
#pragma unroll
              for (int j = 0; j < 4; ++j) { rs += v0[j] + v1[j]; rq += v0[j] * v0[j] + v1[j] * v1[j]; } }
            u32x4 w; w.x = cvt_pk_bf16(v0[0], v0[1]); w.y = cvt_pk_bf16(v0[2], v0[3]); w.z = cvt_pk_bf16(v1[0], v1[1]); w.w = cvt_pk_bf16(v1[2], v1[3]);
            *(u32x4*)(rowp + bj * 128) = w; }
          if (pn >= 4 && pn < 8) { rs += __shfl_xor(rs, 16); rs += __shfl_xor(rs, 32); rq += __shfl_xor(rq, 16); rq += __shfl_xor(rq, 32);
            if (fq == 0) VST[(size_t)(row0 + ai * 128 + m * 16) * 16 + (pn - 4) * 4 + wc] = (f32x2){rs, rq}; } }
    } else if (wc == 0 && fq < 2) {
#pragma unroll
      for (int ai = 0; ai < 2; ++ai)
#pragma unroll
        for (int m = 0; m < 4; ++m) { float* p = DT + (size_t)(row0 + ai * 128 + m * 16) * 16 + 8 * fq; *(f32x4*)p = acc[ai][0][m][0]; *(f32x4*)(p + 4) = acc[ai][0][m][1]; }
    }
  }
};
struct EpiRes {
  static constexpr bool PERM = false, AFTER_DRAIN = false;
  float* X;
  __device__ __forceinline__ void operator()(const f32x4 (&acc)[2][2][4][2], const Unit& u, int wr, int wc, int fr, int fq) const {
    const int row0 = u.pm * 256 + wr * 64 + fr, col0 = u.pn * 256 + wc * 32 + 4 * fq;
#pragma unroll
    for (int ai = 0; ai < 2; ++ai)
#pragma unroll
      for (int m = 0; m < 4; ++m) { const int row = row0 + ai * 128 + m * 16;
        if (row < T) { float* rowp = X + (size_t)row * 1024 + col0;
#pragma unroll
          for (int bj = 0; bj < 2; ++bj)
#pragma unroll
            for (int n = 0; n < 2; ++n) { f32x4 x = *(const f32x4*)(rowp + bj * 128 + n * 16); *(f32x4*)(rowp + bj * 128 + n * 16) = x * ALPHA + acc[ai][bj][m][n]; } } }
  }
};
struct EpiRelu2 {
  static constexpr bool PERM = true, AFTER_DRAIN = false;
  bf16_t* H;
  __device__ __forceinline__ void operator()(const f32x4 (&acc)[2][2][4][2], const Unit& u, int wr, int wc, int fr, int fq) const {
    const int row0 = u.pm * 256 + wr * 64 + fr, col0 = u.pn * 256 + wc * 32 + 8 * fq;
#pragma unroll
    for (int ai = 0; ai < 2; ++ai)
#pragma unroll
      for (int m = 0; m < 4; ++m) { bf16_t* rowp = H + (size_t)(row0 + ai * 128 + m * 16) * DFF + col0;
#pragma unroll
        for (int bj = 0; bj < 2; ++bj) { f32x4 v0 = acc[ai][bj][m][0], v1 = acc[ai][bj][m][1];
#pragma unroll
          for (int j = 0; j < 4; ++j) { const float a = fmaxf(v0[j], 0.f), b = fmaxf(v1[j], 0.f); v0[j] = a * a; v1[j] = b * b; }
          u32x4 w; w.x = cvt_pk_bf16(v0[0], v0[1]); w.y = cvt_pk_bf16(v0[2], v0[3]); w.z = cvt_pk_bf16(v1[0], v1[1]); w.w = cvt_pk_bf16(v1[2], v1[3]);
          *(u32x4*)(rowp + bj * 128) = w; } }
  }
};

struct CvtJob { const float* W; bf16_t* Wt; int K, N, ntn, ntiles; };
__device__ __forceinline__ void cvt_run(LAS unsigned char* lds, const CvtJob& j0, const CvtJob& j1, const CvtJob& j2, int j, int nw) {
  LAS float* tl = (LAS float*)lds; int tid_ = threadIdx.x; asm volatile("" : "+v"(tid_)); const int tid = tid_;
  const int e0 = j0.ntiles, e1 = e0 + j1.ntiles, e2 = e1 + j2.ntiles;
  for (int t0 = j * 4; t0 < e2; t0 += nw * 4) {
    f32x4 v[4][2];
#pragma unroll
    for (int u = 0; u < 4; ++u) { const int t = t0 + u; v[u][0] = (f32x4){0.f, 0.f, 0.f, 0.f}; v[u][1] = v[u][0];
      if (t < e2) { const CvtJob& J = t < e0 ? j0 : (t < e1 ? j1 : j2); const int tt = t < e0 ? t : (t < e1 ? t - e0 : t - e1); const int kt = tt / J.ntn, nt = tt - kt * J.ntn, k0 = kt * 64, n0 = nt * 64, nn = (tid & 15) * 4;
        if (n0 + nn < J.N) { v[u][0] = *(const f32x4*)(J.W + (size_t)(k0 + (tid >> 4)) * J.N + n0 + nn); v[u][1] = *(const f32x4*)(J.W + (size_t)(k0 + (tid >> 4) + 32) * J.N + n0 + nn); } } }
#pragma unroll
    for (int u = 0; u < 4; ++u)
#pragma unroll
      for (int it = 0; it < 2; ++it) { LAS float* d = tl + u * 4160 + ((tid >> 4) + it * 32) * 65 + (tid & 15) * 4; d[0] = v[u][it][0]; d[1] = v[u][it][1]; d[2] = v[u][it][2]; d[3] = v[u][it][3]; }
    __syncthreads();
#pragma unroll
    for (int u = 0; u < 4; ++u) { const int t = t0 + u;
      if (t < e2) { const CvtJob& J = t < e0 ? j0 : (t < e1 ? j1 : j2); const int tt = t < e0 ? t : (t < e1 ? t - e0 : t - e1); const int kt = tt / J.ntn, nt = tt - kt * J.ntn, k0 = kt * 64, n0 = nt * 64;
        const int nn = tid >> 3, kk = (tid & 7) * 8; float f[8];
#pragma unroll
        for (int i = 0; i < 8; ++i) f[i] = tl[u * 4160 + (kk + i) * 65 + nn];
        u32x4 w; w.x = cvt_pk_bf16(f[0], f[1]); w.y = cvt_pk_bf16(f[2], f[3]); w.z = cvt_pk_bf16(f[4], f[5]); w.w = cvt_pk_bf16(f[6], f[7]);
        *(u32x4*)(J.Wt + (size_t)(n0 + nn) * J.K + k0 + kk) = w; } }
    __syncthreads();
  }
}
template <int R4> __device__ __forceinline__ bf16x8 tr_frag(unsigned addr) {
  u32x2 lo, hi; asm volatile("ds_read_b64_tr_b16 %0, %2\n\tds_read_b64_tr_b16 %1, %2 offset:%3\n\ts_waitcnt lgkmcnt(0)" : "=&v"(lo), "=&v"(hi) : "v"(addr), "n"(R4) : "memory");
  u32x4 r; r.x = lo.x; r.y = lo.y; r.z = hi.x; r.w = hi.y; return __builtin_bit_cast(bf16x8, r);
}

constexpr int PT = 136;
__device__ __forceinline__ void gmlp_item(LAS unsigned char* lds, const Lp& p, int l, int rowbase, int nrows, int h, float* vout  ) {
  int tid_ = threadIdx.x; asm volatile("" : "+v"(tid_)); const int tid = tid_, wid = __builtin_amdgcn_readfirstlane(tid >> 6), lane = tid & 63, fr = lane & 15, fq = lane >> 4;
  const bf16_t* VG = (const bf16_t*)(p.ws + WS_VG); const bf16_t* UG = (const bf16_t*)(p.ws + WS_UG); bf16_t* MIX = (bf16_t*)(p.ws + WS_MIX);
  const bf16_t* GW = (const bf16_t*)(p.ws + WS_GW) + (size_t)(l * 8 + h) * 128 * 128;
  LAS bf16_t* vimg = (LAS bf16_t*)lds; LAS f32x2* st = (LAS f32x2*)(lds + 128 * PT * 2);
  if (tid < 128) { float mean = 0.f, rstd = 0.f;
    if (tid < nrows) { const f32x4* q = (const f32x4*)(p.ws + WS_VST + (size_t)(rowbase + tid) * 128); float s = 0.f, ss = 0.f;
#pragma unroll
      for (int i = 0; i < 8; ++i) { const f32x4 v = q[i]; s += v[0] + v[2]; ss += v[1] + v[3]; }
      mean = s * (1.0f / 1024.0f); rstd = rsqrtf(fmaxf(ss * (1.0f / 1024.0f) - mean * mean, 0.f) + LN_EPS); }
    st[tid] = (f32x2){mean, rstd}; }
  __syncthreads();
  { const int s = tid >> 2, cg0 = (tid & 3) * 32; const f32x2 ms = st[s]; const float* G = p.in[5] + l * 1024 + h * 128 + cg0; const float* Bb = p.in[6] + l * 1024 + h * 128 + cg0;
#pragma unroll
    for (int i = 0; i < 4; ++i) { float f[8];
      if (s < nrows) { unpack8(*(const u32x4*)(VG + (size_t)(rowbase + s) * 1024 + h * 128 + cg0 + 8 * i), f);
#pragma unroll
        for (int e = 0; e < 8; ++e) f[e] = (f[e] - ms.x) * ms.y * G[8 * i + e] + Bb[8 * i + e];
        if (vout) { float* o = vout + (size_t)s * 1024 + h * 128 + cg0 + 8 * i; *(f32x4*)o = (f32x4){f[0], f[1], f[2], f[3]}; *(f32x4*)(o + 4) = (f32x4){f[4], f[5], f[6], f[7]}; }
      } else {
#pragma unroll
        for (int e = 0; e < 8; ++e) f[e] = 0.f; }
      u32x4 w; w.x = cvt_pk_bf16(f[0], f[1]); w.y = cvt_pk_bf16(f[2], f[3]); w.z = cvt_pk_bf16(f[4], f[5]); w.w = cvt_pk_bf16(f[6], f[7]);
      *(LAS u32x4*)(vimg + s * PT + cg0 + 8 * i) = w; } }
  __syncthreads();
  if (wid * 16 < nrows) {
    f32x4 acc[8];
#pragma unroll
    for (int n = 0; n < 8; ++n) acc[n] = (f32x4){0.f, 0.f, 0.f, 0.f};
    const int nks = (wid * 16 + 15) / 32 + 1; const unsigned lbase = (unsigned)(size_t)lds;
    for (int ks = 0; ks < nks; ++ks) { const bf16x8 a = *(const bf16x8*)(GW + (size_t)(wid * 16 + fr) * 128 + ks * 32 + fq * 8);
#pragma unroll
      for (int n = 0; n < 8; ++n) { const bf16x8 b = tr_frag<4 * PT * 2>(lbase + (unsigned)(((ks * 32 + fq * 8 + (fr >> 2)) * PT + n * 16 + 4 * (fr & 3)) * 2)); acc[n] = __builtin_amdgcn_mfma_f32_16x16x32_bf16(b, a, acc[n], 0, 0, 0); } }
    const int t = wid * 16 + fr;
    if (t < nrows) { const float bs = p.in[8][(l * 8 + h) * 128 + t]; const size_t row = (size_t)(rowbase + t);
#pragma unroll
      for (int n = 0; n < 8; ++n) { const int col = h * 128 + n * 16 + fq * 4; const u32x2 ug = *(const u32x2*)(UG + row * 1024 + col);
        u32x2 w; w.x = cvt_pk_bf16(lo2f(ug.x) * (acc[n][0] + bs), hi2f(ug.x) * (acc[n][1] + bs)); w.y = cvt_pk_bf16(lo2f(ug.y) * (acc[n][2] + bs), hi2f(ug.y) * (acc[n][3] + bs));
        *(u32x2*)(MIX + row * MIXW + col) = w; } } }
  __syncthreads();
}
constexpr int XP = 72;
constexpr int L_BM = 0, L_CM = 128 * PT * 2, L_XH = 2 * 128 * PT * 2, L_XS = L_XH + 128 * XP * 2, L_AC = L_XS + 128 * XP * 2, L_DT = L_AC + 4096;
static_assert(L_DT + 4096 <= LDS_BYTES, "LDS");
__device__ __forceinline__ size_t st_item(int b, int c, int h, bool sample) { return sample ? (size_t)(2048 + b * 16 + h) : (size_t)((b * 16 + c) * 16 + h); }
__device__ __forceinline__ void ssd_ma_item(LAS unsigned char* lds, const Lp& p, int l, int b, int c, int g, bool sample) {
  int tid_ = threadIdx.x; asm volatile("" : "+v"(tid_)); const int tid = tid_, wid = __builtin_amdgcn_readfirstlane(tid >> 6), lane = tid & 63, fr = lane & 15, fq = lane >> 4;
  const int seq0 = sample ? TPR + b * DSEQ : b * SEQ, pos0 = c * 128, crow = seq0 + pos0, nrows = sample ? DSEQ : 128;
  const bf16_t* XBC = (const bf16_t*)(p.ws + WS_XBC); const float* DT = (const float*)(p.ws + WS_DT);
  LAS bf16_t* Bm = (LAS bf16_t*)(lds + L_BM); LAS bf16_t* Cm = (LAS bf16_t*)(lds + L_CM); LAS bf16_t* xh = (LAS bf16_t*)(lds + L_XH); LAS bf16_t* xs = (LAS bf16_t*)(lds + L_XS);
  LAS float* acum = (LAS float*)(lds + L_AC); LAS float* dtv = (LAS float*)(lds + L_DT); const unsigned lbase = (unsigned)(size_t)lds;
  const float* convw = p.in[9] + (size_t)l * 4 * XW; const float* convb = p.in[10] + (size_t)l * XW; const float* cstate = p.in[3] + (size_t)(l * 8 + b) * 3 * XW;
  { const int h = g * 8 + wid; const float av = -__expf(p.in[12][l * 16 + h]), dtb = p.in[11][l * 16 + h];
    float d0 = 0.f, d1 = 0.f; if (lane < nrows) d0 = softplus_f(DT[(size_t)(crow + lane) * 16 + h] + dtb); if (lane + 64 < nrows) d1 = softplus_f(DT[(size_t)(crow + lane + 64) * 16 + h] + dtb);
    float s0 = d0 * av, s1 = d1 * av;
#pragma unroll
    for (int o = 1; o < 64; o <<= 1) { const float t0 = __shfl_up(s0, o), t1 = __shfl_up(s1, o); if (lane >= o) { s0 += t0; s1 += t1; } }
    s1 += __shfl(s0, 63);
    acum[wid * 128 + lane] = s0; acum[wid * 128 + 64 + lane] = s1; dtv[wid * 128 + lane] = d0; dtv[wid * 128 + 64 + lane] = d1;
    float* AC = (float*)(p.ws + WS_ACUM); if (lane < nrows) AC[(size_t)(crow + lane) * 16 + h] = s0; if (lane + 64 < nrows) AC[(size_t)(crow + lane + 64) * 16 + h] = s1;
    if (lane == 63) ((float*)(p.ws + WS_DEC))[st_item(b, c, h, sample)] = exp_f(s1); }
  { const int cgi = tid & 31, rr = tid >> 5; const int nn = (cgi & 15) * 8, ch = (cgi < 16 ? 1024 : 1280) + g * 128 + nn; const int j0 = rr * 8;
    float w0[8], w1[8], w2[8], w3[8], bb[8], p0[8], p1[8], p2[8];
#pragma unroll
    for (int e = 0; e < 8; ++e) { w0[e] = convw[ch + e]; w1[e] = convw[XW + ch + e]; w2[e] = convw[2 * XW + ch + e]; w3[e] = convw[3 * XW + ch + e]; bb[e] = convb[ch + e]; }
#pragma unroll
    for (int i = 0; i < 3; ++i) { const int pos = pos0 + j0 - 3 + i; float f[8];
      if (pos >= 0) unpack8(*(const u32x4*)(XBC + (size_t)(seq0 + pos) * XW + ch), f);
      else {
#pragma unroll
        for (int e = 0; e < 8; ++e) f[e] = sample ? cstate[(3 + pos) * XW + ch + e] : 0.f; }
#pragma unroll
      for (int e = 0; e < 8; ++e) { if (i == 0) p0[e] = f[e]; else if (i == 1) p1[e] = f[e]; else p2[e] = f[e]; } }
    bf16_t* CN = (bf16_t*)(p.ws + WS_CN);
#pragma unroll
    for (int jj = 0; jj < 8; ++jj) { const int j = j0 + jj; float cur[8], o[8]; unpack8(*(const u32x4*)(XBC + (size_t)(crow + j) * XW + ch), cur);
#pragma unroll
      for (int e = 0; e < 8; ++e) { const float v = bb[e] + w0[e] * p0[e] + w1[e] * p1[e] + w2[e] * p2[e] + w3[e] * cur[e]; o[e] = (j < nrows) ? silu_f(v) : 0.f; p0[e] = p1[e]; p1[e] = p2[e]; p2[e] = cur[e]; }
      u32x4 w; w.x = cvt_pk_bf16(o[0], o[1]); w.y = cvt_pk_bf16(o[2], o[3]); w.z = cvt_pk_bf16(o[4], o[5]); w.w = cvt_pk_bf16(o[6], o[7]);
      if (cgi < 16) *(LAS u32x4*)(Bm + j * PT + nn) = w; else { *(LAS u32x4*)(Cm + j * PT + nn) = w; if (j < nrows) *(u32x4*)(CN + (size_t)(crow + j) * 256 + g * 128 + nn) = w; } } }
  __syncthreads();
  f32x4 cb[8];
#pragma unroll
  for (int jt = 0; jt < 8; ++jt) cb[jt] = (f32x4){0.f, 0.f, 0.f, 0.f};
#pragma unroll
  for (int ks = 0; ks < 4; ++ks) { const bf16x8 bq = *(const LAS bf16x8*)(Cm + (wid * 16 + fr) * PT + ks * 32 + fq * 8);
#pragma unroll
    for (int jt = 0; jt < 8; ++jt) if (jt <= wid) { const bf16x8 a = *(const LAS bf16x8*)(Bm + (jt * 16 + fr) * PT + ks * 32 + fq * 8); cb[jt] = __builtin_amdgcn_mfma_f32_16x16x32_bf16(a, bq, cb[jt], 0, 0, 0); } }
  __syncthreads();
  LAS bf16_t* Pm = Cm;
  bf16_t* YD = (bf16_t*)(p.ws + WS_YD); bf16_t* ST = (bf16_t*)(p.ws + WS_ST);
  for (int h8 = 0; h8 < 8; ++h8) { const int h = g * 8 + h8; const float Dh = p.in[13][l * 16 + h]; const float alast = acum[h8 * 128 + 127];
    { const int cgi = tid & 7, rr = tid >> 3; const int nn = cgi * 8, ch = h * 64 + nn, j0 = rr * 2; float w0[8], w1[8], w2[8], w3[8], bb[8], r[5][8];
#pragma unroll
      for (int e = 0; e < 8; ++e) { w0[e] = convw[ch + e]; w1[e] = convw[XW + ch + e]; w2[e] = convw[2 * XW + ch + e]; w3[e] = convw[3 * XW + ch + e]; bb[e] = convb[ch + e]; }
#pragma unroll
      for (int i = 0; i < 5; ++i) { const int pos = pos0 + j0 - 3 + i;
        if (pos >= 0) unpack8(*(const u32x4*)(XBC + (size_t)(seq0 + pos) * XW + ch), r[i]);
        else {
#pragma unroll
          for (int e = 0; e < 8; ++e) r[i][e] = sample ? cstate[(3 + pos) * XW + ch + e] : 0.f; } }
#pragma unroll
      for (int jj = 0; jj < 2; ++jj) { const int j = j0 + jj; float o[8], os[8]; const float wj = exp_f(alast - acum[h8 * 128 + j]) * dtv[h8 * 128 + j];
#pragma unroll
        for (int e = 0; e < 8; ++e) { const float v = bb[e] + w0[e] * r[jj][e] + w1[e] * r[jj + 1][e] + w2[e] * r[jj + 2][e] + w3[e] * r[jj + 3][e]; o[e] = (j < nrows) ? silu_f(v) : 0.f; os[e] = o[e] * wj; }
        u32x4 w; w.x = cvt_pk_bf16(o[0], o[1]); w.y = cvt_pk_bf16(o[2], o[3]); w.z = cvt_pk_bf16(o[4], o[5]); w.w = cvt_pk_bf16(o[6], o[7]); *(LAS u32x4*)(xh + j * XP + nn) = w;
        w.x = cvt_pk_bf16(os[0], os[1]); w.y = cvt_pk_bf16(os[2], os[3]); w.z = cvt_pk_bf16(os[4], os[5]); w.w = cvt_pk_bf16(os[6], os[7]); *(LAS u32x4*)(xs + j * XP + nn) = w; } }
    { const int i = wid * 16 + fr; const float ai = acum[h8 * 128 + i];
#pragma unroll
      for (int jt = 0; jt < 8; ++jt) { float v[4];
#pragma unroll
        for (int r = 0; r < 4; ++r) { const int j = jt * 16 + fq * 4 + r; float x = 0.f; if (jt <= wid && j <= i) x = cb[jt][r] * exp_f(ai - acum[h8 * 128 + j]) * dtv[h8 * 128 + j]; if (j == i) x += Dh; v[r] = x; }
        u32x2 w; w.x = cvt_pk_bf16(v[0], v[1]); w.y = cvt_pk_bf16(v[2], v[3]); *(LAS u32x2*)(Pm + i * PT + jt * 16 + fq * 4) = w; } }
    __syncthreads();
    { f32x4 y[4], hs[4];
#pragma unroll
      for (int pt = 0; pt < 4; ++pt) { y[pt] = (f32x4){0.f, 0.f, 0.f, 0.f}; hs[pt] = y[pt]; }
      const int nks = (wid * 16 + 15) / 32 + 1;
      for (int ks = 0; ks < nks; ++ks) { const bf16x8 bq = *(const LAS bf16x8*)(Pm + (wid * 16 + fr) * PT + ks * 32 + fq * 8);
#pragma unroll
        for (int pt = 0; pt < 4; ++pt) { const bf16x8 a = tr_frag<4 * XP * 2>(lbase + L_XH + (unsigned)(((ks * 32 + fq * 8 + (fr >> 2)) * XP + pt * 16 + 4 * (fr & 3)) * 2)); y[pt] = __builtin_amdgcn_mfma_f32_16x16x32_bf16(a, bq, y[pt], 0, 0, 0); } }
#pragma unroll
      for (int ks = 0; ks < 4; ++ks) { const bf16x8 a = tr_frag<4 * PT * 2>(lbase + L_BM + (unsigned)(((ks * 32 + fq * 8 + (fr >> 2)) * PT + wid * 16 + 4 * (fr & 3)) * 2));
#pragma unroll
        for (int pt = 0; pt < 4; ++pt) { const bf16x8 bq = tr_frag<4 * XP * 2>(lbase + L_XS + (unsigned)(((ks * 32 + fq * 8 + (fr >> 2)) * XP + pt * 16 + 4 * (fr & 3)) * 2)); hs[pt] = __builtin_amdgcn_mfma_f32_16x16x32_bf16(a, bq, hs[pt], 0, 0, 0); } }
      const int i = wid * 16 + fr; bf16_t* sti = ST + st_item(b, c, h, sample) * 8192;
#pragma unroll
      for (int pt = 0; pt < 4; ++pt) { u32x2 w;
        if (i < nrows) { w.x = cvt_pk_bf16(y[pt][0], y[pt][1]); w.y = cvt_pk_bf16(y[pt][2], y[pt][3]); *(u32x2*)(YD + (size_t)(crow + i) * 1024 + h * 64 + pt * 16 + fq * 4) = w; }
        w.x = cvt_pk_bf16(hs[pt][0], hs[pt][1]); w.y = cvt_pk_bf16(hs[pt][2], hs[pt][3]); *(u32x2*)(sti + (pt * 16 + fr) * 128 + wid * 16 + fq * 4) = w; } }
    __syncthreads();
  }
}
__device__ __forceinline__ void ssd_scan_phase(const Lp& p, int l) {
  bf16_t* ST = (bf16_t*)(p.ws + WS_ST); const float* DEC = (const float*)(p.ws + WS_DEC);
  for (int gid = p.bid * 512 + p.tid; gid < 8 * 16 * 64 * 16; gid += p.G * 512) { const int e8 = gid & 15, pp = (gid >> 4) & 63, h = (gid >> 10) & 15, b = gid >> 14; const size_t eoff = (size_t)pp * 128 + e8 * 8;
    u32x4 sv[16]; float dc[16];
#pragma unroll
    for (int c = 0; c < 16; ++c) { sv[c] = *(const u32x4*)(ST + st_item(b, c, h, false) * 8192 + eoff); dc[c] = DEC[st_item(b, c, h, false)]; }
    float hr[8];
#pragma unroll
    for (int e = 0; e < 8; ++e) hr[e] = 0.f;
#pragma unroll
    for (int c = 0; c < 16; ++c) { u32x4 w; w.x = cvt_pk_bf16(hr[0], hr[1]); w.y = cvt_pk_bf16(hr[2], hr[3]); w.z = cvt_pk_bf16(hr[4], hr[5]); w.w = cvt_pk_bf16(hr[6], hr[7]);
      *(u32x4*)(ST + st_item(b, c, h, false) * 8192 + eoff) = w; float f[8]; unpack8(sv[c], f);
#pragma unroll
      for (int e = 0; e < 8; ++e) hr[e] = dc[c] * hr[e] + f[e]; }
    { float* o = p.out + O_SSMP + (size_t)((l * 8 + b) * 16 + h) * 8192 + eoff; *(f32x4*)o = (f32x4){hr[0], hr[1], hr[2], hr[3]}; *(f32x4*)(o + 4) = (f32x4){hr[4], hr[5], hr[6], hr[7]}; }
    { const float* h0 = p.in[2] + (size_t)((l * 8 + b) * 16 + h) * 8192 + eoff; const f32x4 a = *(const f32x4*)h0, bq = *(const f32x4*)(h0 + 4); bf16_t* sp = ST + st_item(b, 0, h, true) * 8192 + eoff;
      float f[8]; unpack8(*(const u32x4*)sp, f); const float d = DEC[st_item(b, 0, h, true)];
      u32x4 w; w.x = cvt_pk_bf16(a[0], a[1]); w.y = cvt_pk_bf16(a[2], a[3]); w.z = cvt_pk_bf16(bq[0], bq[1]); w.w = cvt_pk_bf16(bq[2], bq[3]); *(u32x4*)sp = w;
      float* o = p.out + O_SSMS + (size_t)((l * 8 + b) * 16 + h) * 8192 + eoff;
      *(f32x4*)o = (f32x4){d * a[0] + f[0], d * a[1] + f[1], d * a[2] + f[2], d * a[3] + f[3]}; *(f32x4*)(o + 4) = (f32x4){d * bq[0] + f[4], d * bq[1] + f[5], d * bq[2] + f[6], d * bq[3] + f[7]}; }
  }
}
__device__ __forceinline__ void ssd_mc_item(const Lp& p, int l, int b, int c, int g, bool sample) {
  int tid_ = threadIdx.x; asm volatile("" : "+v"(tid_)); const int tid = tid_, wid = __builtin_amdgcn_readfirstlane(tid >> 6), lane = tid & 63, fr = lane & 15, fq = lane >> 4;
  const int crow = (sample ? TPR + b * DSEQ : b * SEQ) + c * 128, nrows = sample ? DSEQ : 128; const int i = wid * 16 + fr; const size_t row = (size_t)(crow + i); const bool ok = i < nrows;
  if (wid * 16 >= nrows) return;
  const bf16_t* CN = (const bf16_t*)(p.ws + WS_CN); const bf16_t* ST = (const bf16_t*)(p.ws + WS_ST); const bf16_t* YD = (const bf16_t*)(p.ws + WS_YD); const bf16_t* Z = (const bf16_t*)(p.ws + WS_Z);
  const float* AC = (const float*)(p.ws + WS_ACUM); bf16_t* MIX = (bf16_t*)(p.ws + WS_MIX);
  bf16x8 cf[4];
#pragma unroll
  for (int ks = 0; ks < 4; ++ks) cf[ks] = *(const bf16x8*)(CN + row * 256 + g * 128 + ks * 32 + fq * 8);
  float ss = 0.f;
#pragma unroll 1
  for (int h8 = 0; h8 < 8; ++h8) { const int h = g * 8 + h8; const bf16_t* hs = ST + st_item(b, c, h, sample) * 8192; f32x4 yy[4];
#pragma unroll
    for (int pt = 0; pt < 4; ++pt) yy[pt] = (f32x4){0.f, 0.f, 0.f, 0.f};
#pragma unroll
    for (int ks = 0; ks < 4; ++ks)
#pragma unroll
      for (int pt = 0; pt < 4; ++pt) { const bf16x8 a = *(const bf16x8*)(hs + (pt * 16 + fr) * 128 + ks * 32 + fq * 8); yy[pt] = __builtin_amdgcn_mfma_f32_16x16x32_bf16(a, cf[ks], yy[pt], 0, 0, 0); }
    const float ei = ok ? exp_f(AC[row * 16 + h]) : 0.f;
#pragma unroll
    for (int pt = 0; pt < 4; ++pt) { const int col = h * 64 + pt * 16 + fq * 4; u32x2 yd = {0u, 0u}, zz = {0u, 0u}; if (ok) { yd = *(const u32x2*)(YD + row * 1024 + col); zz = *(const u32x2*)(Z + row * 1024 + col); }
      f32x4 v = yy[pt] * ei; v[0] = (v[0] + lo2f(yd.x)) * silu_f(lo2f(zz.x)); v[1] = (v[1] + hi2f(yd.x)) * silu_f(hi2f(zz.x)); v[2] = (v[2] + lo2f(yd.y)) * silu_f(lo2f(zz.y)); v[3] = (v[3] + hi2f(yd.y)) * silu_f(hi2f(zz.y));
      if (ok) { ss += (v[0] * v[0] + v[1] * v[1]) + (v[2] * v[2] + v[3] * v[3]); u32x2 w; w.x = cvt_pk_bf16(v[0], v[1]); w.y = cvt_pk_bf16(v[2], v[3]); *(u32x2*)(MIX + row * MIXW + 1024 + col) = w; } } }
  ss += __shfl_xor(ss, 16); ss += __shfl_xor(ss, 32);
  const float rstd = rsqrtf(ss * (1.0f / 512.0f) + RMS_EPS); const float* gm = p.in[14] + l * 1024 + g * 512;
  if (ok) {
#pragma unroll 4
    for (int q = 0; q < 32; ++q) { const int cc = (q >> 2) * 64 + (q & 3) * 16 + fq * 4; u32x2* ptr = (u32x2*)(MIX + row * MIXW + 1024 + g * 512 + cc); const u32x2 w0 = *ptr; const f32x4 gv = *(const f32x4*)(gm + cc);
      u32x2 w; w.x = cvt_pk_bf16(lo2f(w0.x) * rstd * gv[0], hi2f(w0.x) * rstd * gv[1]); w.y = cvt_pk_bf16(lo2f(w0.y) * rstd * gv[2], hi2f(w0.y) * rstd * gv[3]); *ptr = w; } }
}
__device__ __forceinline__ void ln_phase(const Lp& p, const float* __restrict__ g, const float* __restrict__ b, float* Xo, bf16_t* Xb) {
  const int tid = p.tid, wid = tid >> 6, lane = tid & 63; const float* X = p.out;
  f32x4 gv[4], bv[4];
#pragma unroll
  for (int i = 0; i < 4; ++i) { gv[i] = *(const f32x4*)(g + i * 256 + lane * 4); bv[i] = *(const f32x4*)(b + i * 256 + lane * 4); }
  for (int row = p.bid * 8 + wid; row < T; row += p.G * 8) { f32x4 v[4]; float s = 0.f;
#pragma unroll
    for (int i = 0; i < 4; ++i) { v[i] = *(const f32x4*)(X + (size_t)row * 1024 + i * 256 + lane * 4); s += (v[i][0] + v[i][1]) + (v[i][2] + v[i][3]); }
#pragma unroll
    for (int o = 32; o >= 1; o >>= 1) s += __shfl_xor(s, o);
    const float mean = s * (1.0f / 1024.0f); float q = 0.f;
#pragma unroll
    for (int i = 0; i < 4; ++i) { const f32x4 d = v[i] - mean; q += (d[0] * d[0] + d[1] * d[1]) + (d[2] * d[2] + d[3] * d[3]); }
#pragma unroll
    for (int o = 32; o >= 1; o >>= 1) q += __shfl_xor(q, o);
    const float rstd = rsqrtf(q * (1.0f / 1024.0f) + LN_EPS);
#pragma unroll
    for (int i = 0; i < 4; ++i) { const f32x4 y = (v[i] - mean) * rstd * gv[i] + bv[i]; *(f32x4*)(Xo + (size_t)row * 1024 + i * 256 + lane * 4) = y;
      u32x2 w; w.x = cvt_pk_bf16(y[0], y[1]); w.y = cvt_pk_bf16(y[2], y[3]); *(u32x2*)(Xb + (size_t)row * 1024 + i * 256 + lane * 4) = w; } }
}
constexpr int NK = 9, NPH = 1 + NK * DEPTH;
__device__ __forceinline__ void p0_phase(LAS unsigned char* lds, const Lp& p) {
  const int tid = p.tid, bid = p.bid, G = p.G; bf16_t* Xb = (bf16_t*)(p.ws + WS_XB); bf16_t* GW = (bf16_t*)(p.ws + WS_GW);
  for (size_t i = (size_t)bid * 512 + tid; i < (size_t)TP * 128; i += (size_t)G * 512) { const size_t e = i * 8; u32x4 w = {0u, 0u, 0u, 0u};
    if (e < (size_t)T * 1024) { const float* src = e < (size_t)TPR * 1024 ? p.in[0] + e : p.in[1] + (e - (size_t)TPR * 1024); const f32x4 a = *(const f32x4*)src, b = *(const f32x4*)(src + 4);
      *(f32x4*)(p.out + e) = a; *(f32x4*)(p.out + e + 4) = b; w.x = cvt_pk_bf16(a[0], a[1]); w.y = cvt_pk_bf16(a[2], a[3]); w.z = cvt_pk_bf16(b[0], b[1]); w.w = cvt_pk_bf16(b[2], b[3]); }
    *(u32x4*)(Xb + e) = w; }
  for (int i = bid * 512 + tid; i < DEPTH * 8 * 128 * 128; i += G * 512) { const int s = i & 127, t = (i >> 7) & 127; GW[i] = s <= t ? f2bf(p.in[7][i]) : (bf16_t)0; }
  const CvtJob j0{p.in[4], (bf16_t*)(p.ws + WS_WIN), 1024, NIN, NINP / 64, 16 * (NINP / 64)}, jn{nullptr, nullptr, 64, 64, 1, 0};
  cvt_run(lds, j0, jn, jn, bid, G);
}
__device__ __forceinline__ void ma_phase(LAS unsigned char* lds, const Lp& p, int l) {
  const int tid = p.tid, bid = p.bid, G = p.G; const bf16_t* XBC = (const bf16_t*)(p.ws + WS_XBC);
  for (int i = bid * 512 + tid; i < 2 * 8 * 3 * XW; i += G * 512) { const int smp = i / (8 * 3 * XW), r = i - smp * (8 * 3 * XW), b = r / (3 * XW), k = (r / XW) % 3, ch = r % XW;
    const size_t row = smp ? (size_t)(TPR + b * DSEQ + DSEQ - 3 + k) : (size_t)(b * SEQ + SEQ - 3 + k);
    p.out[(smp ? O_CONVS : O_CONVP) + (size_t)l * 8 * 3 * XW + r] = bf2f(XBC[row * XW + ch]); }
  for (int it = bid; it < 272; it += G) { const bool smp = it >= 256; const int i2 = it - 256;
    ssd_ma_item(lds, p, l, smp ? i2 >> 1 : it >> 5, smp ? 0 : (it >> 1) & 15, it & 1, smp); }
  const int skip = G > 32 ? 16 : 0;
  if (bid >= skip)
    for (int it = bid - skip; it < 1024 + 64; it += G - skip) { const bool smp = it >= 1024; const int i2 = it - 1024;
      gmlp_item(lds, p, l, smp ? TPR + (i2 >> 3) * DSEQ : (it >> 7) * SEQ + ((it >> 3) & 15) * 128, smp ? DSEQ : 128, it & 7, smp ? p.out + O_VS + (size_t)((l * 8 + (i2 >> 3)) * DSEQ) * 1024 : nullptr); }
}
__device__ __forceinline__ void mc_phase(LAS unsigned char* lds, const Lp& p, int l) {
  const int bid = p.bid, G = p.G;
  for (int it = bid; it < 272; it += G) { const bool smp = it >= 256; const int i2 = it - 256;
    ssd_mc_item(p, l, smp ? i2 >> 1 : it >> 5, smp ? 0 : (it >> 1) & 15, it & 1, smp); }
  const CvtJob j0{p.in[15] + (size_t)l * 2048 * 1024, (bf16_t*)(p.ws + WS_WOUT), 2048, 1024, 16, 512}, j1{p.in[18] + (size_t)l * 1024 * 4096, (bf16_t*)(p.ws + WS_WF1), 1024, 4096, 64, 1024},
               j2{p.in[19] + (size_t)l * 4096 * 1024, (bf16_t*)(p.ws + WS_WF2), 4096, 1024, 16, 1024};
  cvt_run(lds, j0, j1, j2, bid, G);
}
__global__ void __launch_bounds__(512, 2) mk_fwd(Params pa) {
  extern __shared__ __attribute__((aligned(16))) unsigned char shm[];
  LAS unsigned char* lds = (LAS unsigned char*)shm;
  for (int ph = pa.ph_lo; ph < pa.ph_hi; ++ph) {
    const int l = (ph - 1) / NK, k = (ph - 1) - l * NK;
#ifndef PROBE_REP
#define PROBE_REP 0
#endif
    const int nrep = (ph > 0 && ((PROBE_REP >> k) & 1)) ? 2 : 1;
    for (int rep = 0; rep < nrep; ++rep) {
    int z; asm volatile("s_mov_b32 %0, 0" : "=s"(z));
    const Lp p{InProxy{pa, z}, pa.ws + z, pa.out + z, (int)threadIdx.x + z, (int)blockIdx.x + z, (int)gridDim.x + z};
    const bool dry = rep + 1 < nrep;
    if (ph == 0) p0_phase(lds, p);
    else if (k == 0) {
      pg8::Gemm g{(const bf16_t*)(p.ws + WS_XB), (const bf16_t*)(p.ws + WS_WIN), TP, NINP, 1024}; pg8::StaticOrder S; S.init(TP, NINP, p.G, p.bid);
      EpiIn E{(bf16_t*)(p.ws + WS_UG), (bf16_t*)(p.ws + WS_VG), (bf16_t*)(p.ws + WS_Z), (bf16_t*)(p.ws + WS_XBC), (float*)(p.ws + WS_DT), (f32x2*)(p.ws + WS_VST)};
      pg8::gemm_phase<EpiIn, pg8::StaticOrder, false>(lds, g, S, E, nullptr);
    } else if (k == 1) ma_phase(lds, p, l);
    else if (k == 2) ssd_scan_phase(p, l);
    else if (k == 3) mc_phase(lds, p, l);
    else if (k == 4 || k == 7) {
      pg8::Gemm g{(const bf16_t*)(p.ws + (k == 4 ? WS_MIX : WS_H)), (const bf16_t*)(p.ws + (k == 4 ? WS_WOUT : WS_WF2)), TP, 1024, k == 4 ? MIXW : DFF}; pg8::StaticOrder S; S.init(TP, 1024, p.G, p.bid);
      EpiRes E{dry ? (float*)(p.ws + (k == 4 ? WS_UG : WS_MIX)) : p.out};
      pg8::gemm_phase<EpiRes, pg8::StaticOrder, false>(lds, g, S, E, nullptr);
    } else if (k == 6) {
      pg8::Gemm g{(const bf16_t*)(p.ws + WS_XB), (const bf16_t*)(p.ws + WS_WF1), TP, DFF, 1024}; pg8::StaticOrder S; S.init(TP, DFF, p.G, p.bid);
      EpiRelu2 E{(bf16_t*)(p.ws + WS_H)};
      pg8::gemm_phase<EpiRelu2, pg8::StaticOrder, false>(lds, g, S, E, nullptr);
    } else {
      ln_phase(p, p.in[k == 5 ? 16 : 20] + l * 1024, p.in[k == 5 ? 17 : 21] + l * 1024, dry ? (float*)(p.ws + WS_UG) : p.out, (bf16_t*)(p.ws + (dry ? WS_MIX : WS_XB)));
      if (k == 8 && l + 1 < DEPTH && !dry) { const CvtJob j0{p.in[4] + (size_t)(l + 1) * 1024 * NIN, (bf16_t*)(p.ws + WS_WIN), 1024, NIN, NINP / 64, 16 * (NINP / 64)}, jn{nullptr, nullptr, 64, 64, 1, 0}; cvt_run(lds, j0, jn, jn, p.bid, p.G); }
    }
    }
    if (ph + 1 < pa.ph_hi) cg::this_grid().sync();
  }
}

extern "C" void kernel_launch(void* const* d_in, const int* in_sizes, int n_in, void* d_out, int out_size, void* d_ws, size_t ws_size, hipStream_t stream) {
  static int grid = 0;
  if (grid == 0) {
    if (n_in != 22 || ws_size < WS_END) { fprintf(stderr, "kernel_launch: n_in %d ws %zu (need %zu)\n", n_in, ws_size, (size_t)WS_END); grid = -1; return; }
    int dev = 0, cus = 0, per_cu = 0;
    hipGetDevice(&dev); hipDeviceGetAttribute(&cus, hipDeviceAttributeMultiprocessorCount, dev);
    if (hipFuncSetAttribute((const void*)mk_fwd, hipFuncAttributeMaxDynamicSharedMemorySize, LDS_BYTES) != hipSuccess) { fprintf(stderr, "kernel_launch: hipFuncSetAttribute failed\n"); grid = -1; return; }
    if (hipOccupancyMaxActiveBlocksPerMultiprocessor(&per_cu, (const void*)mk_fwd, 512, LDS_BYTES) != hipSuccess || per_cu < 1) { fprintf(stderr, "kernel_launch: occupancy query gave %d\n", per_cu); per_cu = 1; }
    (void)hipGetLastError();
    grid = cus * per_cu;
  }
  if (grid < 0) return;
  Params p{};
  for (int i = 0; i < 22; ++i) p.in[i] = (const float*)d_in[i];
  p.out = (float*)d_out; p.ws = (unsigned char*)d_ws;
#if defined(MK_MULTI)
  for (int i = 0; i < NPH; ++i) { p.ph_lo = i; p.ph_hi = i + 1; hipLaunchKernelGGL(mk_fwd, dim3(grid), dim3(512), LDS_BYTES, stream, p); }
#else
  p.ph_lo = 0; p.ph_hi = NPH;
  void* args[] = {&p};
  hipError_t e = hipLaunchCooperativeKernel((const void*)mk_fwd, dim3(grid), dim3(512), args, LDS_BYTES, stream);
  if (e != hipSuccess) fprintf(stderr, "cooperative launch failed: %s (grid %d)\n", hipGetErrorString(e), grid);
#endif
}
```

```cpp
#include <hip/hip_runtime.h>
#include <hip/hip_cooperative_groups.h>
#include <cstdio>
namespace cg = cooperative_groups;
namespace pg8 {
#define PG8_LAS __attribute__((address_space(3)))
typedef unsigned short bf16_t;
typedef short bf16x8 __attribute__((ext_vector_type(8)));
typedef float f32x4 __attribute__((ext_vector_type(4)));
typedef unsigned u32x4 __attribute__((ext_vector_type(4)));
constexpr int BM = 256, BK = 64, HALF = 128, HTB = HALF * BK * 2  , STAGE_BYTES = 8 * HTB, NXCD = 8, WGM = 8;

__host__ __device__ __forceinline__ int lds_byte(int r, int c) { const int st = (r >> 4) * 2 + (c >> 5), rr = r & 15, cc = c & 31, ob = rr * 64 + cc * 2; return st * 1024 + (ob ^ (((ob >> 9) & 1) << 5)); }
__host__ __device__ __forceinline__ void stage_rc(int b, int& R, int& C) { const int st = b / 1024, sb = b % 1024, swz = sb ^ (((sb >> 9) & 1) << 5); R = (st >> 1) * 16 + swz / 64; C = (st & 1) * 32 + (swz % 64) / 2; }
__host__ __device__ __forceinline__ int perm32(int rho) { const int n = rho >> 4, i = rho & 15; return 8 * (i >> 2) + 4 * n + (i & 3); }

struct Unit { int pm, pn; };
struct Gemm { const bf16_t* A; const bf16_t* Bt; int M, N, K; };

struct StaticOrder {
    int nM, nN, nwg, G, c;
    __host__ __device__ void init(int M, int N, int G_, int c_) { nM = M / BM; nN = N / BM; nwg = nM * nN; G = G_; c = c_; }
    __host__ __device__ bool next(int i, Unit& u) const {
        const long L = (long)i * G + c; if (L >= nwg) return false;
        int wgid = (int)L; { const int q = nwg / NXCD, r = nwg % NXCD, xcd = wgid % NXCD, off = wgid / NXCD; wgid = (xcd < r ? xcd * (q + 1) : r * (q + 1) + (xcd - r) * q) + off; }
        const int nig = WGM * nN, gid = wgid / nig, fm = gid * WGM, gsz = (nM - fm) < WGM ? (nM - fm) : WGM;
        u.pm = fm + ((wgid % nig) % gsz); u.pn = (wgid % nig) / gsz; return true;
    }
    __device__ __forceinline__ void a_ready(const Unit&) const {}
    __device__ __forceinline__ void done(const Unit&) const {}
};
__device__ __forceinline__ unsigned cvt_pk_bf16(float lo, float hi) { unsigned r; asm volatile("v_cvt_pk_bf16_f32 %0, %1, %2" : "=v"(r) : "v"(lo), "v"(hi)); return r; }
template <class Epi, class Sched, bool STAMP = false>
__device__ __forceinline__ void gemm_phase(PG8_LAS unsigned char* lds, const Gemm g, const Sched& S, const Epi& E, unsigned long long* stamps) {
    int tid_ = threadIdx.x; asm volatile("" : "+v"(tid_)); const int tid = tid_, wid = __builtin_amdgcn_readfirstlane(tid >> 6), lane = tid & 63, wr = wid >> 2, wc = wid & 3, fr = lane & 15, fq = lane >> 4;
    const int K = g.K, nt = K / BK;
    int ts_lo = 0, ts_hi = 0, nts = 0; const unsigned long long rt_entry = STAMP ? (unsigned long long)wall_clock64() : 0ull;
#define PG8_STAMP() do { if (STAMP && wid == 0 && nts < 64) { const unsigned long long _c = (unsigned long long)clock64(); \
        ts_lo = (lane == nts) ? (int)(unsigned)_c : ts_lo; ts_hi = (lane == nts) ? (int)(unsigned)(_c >> 32) : ts_hi; ++nts; } } while (0)
    PG8_STAMP();
    unsigned voffA[2], voffB[2];
#pragma unroll
    for (int i = 0; i < 2; ++i) { int R, C; stage_rc(tid * 16 + i * 8192, R, C); const int Rb = Epi::PERM ? ((R & ~31) + perm32(R & 31)) : R;
        voffA[i] = (unsigned)(R * K + C) * 2u; voffB[i] = (unsigned)(Rb * K + C) * 2u; }
    const size_t kstep = (size_t)(BK * 2);
    const size_t hstep = (size_t)HALF * K * 2;
    const size_t tstep = 2 * hstep;
    const unsigned ldsw = (unsigned)wid * 1024u;
    const int aoff = lds_byte(wr * 64 + fr, fq * 8), boff = lds_byte(wc * 32 + fr, fq * 8);
#define PG8_SA(b, h) (((b) * 2 + (h)) * HTB)
#define PG8_SB(b, h) ((4 + (b) * 2 + (h)) * HTB)
#define PG8_STAGE(bufoff, gbase, voff) do { _Pragma("unroll") for (int _i = 0; _i < 2; ++_i) \
        __builtin_amdgcn_global_load_lds((const unsigned*)((const char*)(gbase) + (voff)[_i]), (PG8_LAS unsigned*)(lds + (bufoff) + ldsw + _i * 8192), 16, 0, 0); } while (0)
#define PG8_LDA(dst, b, h) do { _Pragma("unroll") for (int m = 0; m < 4; ++m) _Pragma("unroll") for (int k = 0; k < 2; ++k) dst[m][k] = *(const PG8_LAS bf16x8*)(lds + PG8_SA(b, h) + aoff + m * 2048 + k * 1024); } while (0)
#define PG8_LDB(dst, b, h) do { _Pragma("unroll") for (int n = 0; n < 2; ++n) _Pragma("unroll") for (int k = 0; k < 2; ++k) dst[n][k] = *(const PG8_LAS bf16x8*)(lds + PG8_SB(b, h) + boff + n * 2048 + k * 1024); } while (0)
#define PG8_MMA(ai, bj, At, Bt) do { __builtin_amdgcn_s_setprio(1); _Pragma("unroll") for (int m = 0; m < 4; ++m) _Pragma("unroll") for (int n = 0; n < 2; ++n) _Pragma("unroll") for (int k = 0; k < 2; ++k) \
        acc[ai][bj][m][n] = __builtin_amdgcn_mfma_f32_16x16x32_bf16(Bt[n][k], At[m][k], acc[ai][bj][m][n], 0, 0, 0); __builtin_amdgcn_s_setprio(0); } while (0)
#define PG8_WAIT_V(n) asm volatile("s_waitcnt vmcnt(" #n ")" ::: "memory")
#define PG8_WAIT_L(n) asm volatile("s_waitcnt lgkmcnt(" #n ")" ::: "memory")
#define PG8_BAR __builtin_amdgcn_s_barrier()
#define PG8_SCHED __builtin_amdgcn_sched_barrier(0)
    Unit cur, nxt; int ui = 0;
    if (!S.next(0, cur)) return;
    f32x4 acc[2][2][4][2];
#pragma unroll
    for (int a = 0; a < 2; ++a)
#pragma unroll
        for (int b = 0; b < 2; ++b)
#pragma unroll
            for (int m = 0; m < 4; ++m)
#pragma unroll
                for (int n = 0; n < 2; ++n) acc[a][b][m][n] = (f32x4){0.f, 0.f, 0.f, 0.f};
    bf16x8 At[4][2], B0[2][2], B1[2][2];
    const char* cA = (const char*)g.A + (size_t)cur.pm * tstep; const char* cB = (const char*)g.Bt + (size_t)cur.pn * tstep;
    S.a_ready(cur);
    PG8_STAGE(PG8_SB(0, 0), cB, voffB); PG8_STAGE(PG8_SA(0, 0), cA, voffA); PG8_STAGE(PG8_SB(0, 1), cB + hstep, voffB); PG8_STAGE(PG8_SA(0, 1), cA + hstep, voffA);
    if (wr == 1) PG8_BAR;
    PG8_WAIT_V(4); PG8_BAR;
    PG8_STAGE(PG8_SB(1, 0), cB + kstep, voffB); PG8_STAGE(PG8_SA(1, 0), cA + kstep, voffA); PG8_STAGE(PG8_SB(1, 1), cB + hstep + kstep, voffB);
    PG8_WAIT_V(6); PG8_BAR;
    PG8_STAMP();
    for (;;) {
        const bool has_next = S.next(ui + 1, nxt);
        const char* nA = has_next ? (const char*)g.A + (size_t)nxt.pm * tstep : cA; const char* nB = has_next ? (const char*)g.Bt + (size_t)nxt.pn * tstep : cB;
        for (int t = 0; t < nt; t += 2) {
            const bool last = (t == nt - 2);
            const char* a1 = cA + (size_t)(t + 1) * kstep;
            const char* a2 = last ? nA : cA + (size_t)(t + 2) * kstep; const char* b2 = last ? nB : cB + (size_t)(t + 2) * kstep;
            const char* a3 = a2 + kstep; const char* b3 = b2 + kstep;
            if (last && has_next) S.a_ready(nxt);
            PG8_LDB(B0, 0, 0); PG8_SCHED; PG8_LDA(At, 0, 0); PG8_STAGE(PG8_SA(1, 1), a1 + hstep, voffA);
            PG8_WAIT_L(8); PG8_BAR; PG8_WAIT_L(0); PG8_MMA(0, 0, At, B0); PG8_BAR; PG8_SCHED;
            PG8_LDB(B1, 0, 1); PG8_STAGE(PG8_SB(0, 0), b2, voffB);
            PG8_BAR; PG8_WAIT_L(0); PG8_MMA(0, 1, At, B1); PG8_BAR;
            PG8_LDA(At, 0, 1); PG8_STAGE(PG8_SA(0, 0), a2, voffA);
            PG8_BAR; PG8_WAIT_L(0); PG8_MMA(1, 0, At, B0); PG8_BAR; PG8_SCHED;
            PG8_STAGE(PG8_SB(0, 1), b2 + hstep, voffB);
            PG8_WAIT_V(6); PG8_BAR; PG8_MMA(1, 1, At, B1); PG8_BAR;
            PG8_LDB(B0, 1, 0); PG8_SCHED; PG8_LDA(At, 1, 0); PG8_STAGE(PG8_SA(0, 1), a2 + hstep, voffA);
            PG8_WAIT_L(8); PG8_BAR; PG8_WAIT_L(0); PG8_MMA(0, 0, At, B0); PG8_BAR; PG8_SCHED;
            PG8_LDB(B1, 1, 1); PG8_STAGE(PG8_SB(1, 0), b3, voffB);
            PG8_BAR; PG8_WAIT_L(0); PG8_MMA(0, 1, At, B1); PG8_BAR;
            PG8_LDA(At, 1, 1); PG8_STAGE(PG8_SA(1, 0), a3, voffA);
            PG8_BAR; PG8_WAIT_L(0); PG8_MMA(1, 0, At, B0); PG8_BAR; PG8_SCHED;
            PG8_STAGE(PG8_SB(1, 1), b3 + hstep, voffB);
            PG8_WAIT_V(6); PG8_BAR; PG8_MMA(1, 1, At, B1); PG8_BAR;
        }
        PG8_STAMP();
        if constexpr (!Epi::AFTER_DRAIN) { E(acc, cur, wr, wc, fr, fq); S.done(cur); }
        PG8_STAMP();
        if (!has_next) break;
#pragma unroll
        for (int a = 0; a < 2; ++a)
#pragma unroll
            for (int b = 0; b < 2; ++b)
#pragma unroll
                for (int m = 0; m < 4; ++m)
#pragma unroll
                    for (int n = 0; n < 2; ++n) acc[a][b][m][n] = (f32x4){0.f, 0.f, 0.f, 0.f};
        cur = nxt; cA = nA; cB = nB; ++ui;
    }
    PG8_WAIT_V(0);
    if (wr == 0) PG8_BAR;
    PG8_BAR;
    if constexpr (Epi::AFTER_DRAIN) { E.fused(acc, cur, wr, wc, fr, fq, lds, wid, lane); S.done(cur); }
    PG8_STAMP();
    if (STAMP && wid == 0) { stamps[lane] = lane < nts ? (((unsigned long long)(unsigned)ts_hi << 32) | (unsigned)ts_lo) : 0ull;
        if (lane == 62) stamps[62] = rt_entry; if (lane == 63) stamps[63] = (unsigned long long)wall_clock64(); }
#undef PG8_STAMP
#undef PG8_SA
#undef PG8_SB
#undef PG8_STAGE
#undef PG8_LDA
#undef PG8_LDB
#undef PG8_MMA
#undef PG8_WAIT_V
#undef PG8_WAIT_L
#undef PG8_BAR
#undef PG8_SCHED
}
}
using pg8::bf16_t; using pg8::bf16x8; using pg8::f32x4; using pg8::u32x4; using pg8::cvt_pk_bf16; using pg8::Unit;
#define LAS __attribute__((address_space(3)))
typedef unsigned u32x2 __attribute__((ext_vector_type(2)));
typedef float f32x2 __attribute__((ext_vector_type(2)));

constexpr int DM = 1024, NB = 8, SEQ = 2048, DEPTH = 4, DSEQ = 16;
constexpr int TPR = NB * SEQ, T = TPR + NB * DSEQ, TP = 16640;
constexpr int NIN = 4624, NINP = 4864, XW = 1536, DFF = 4096, MIXW = 2048;
constexpr float ALPHA = 1.6817928305074290f;
constexpr float LN_EPS = 1e-5f, RMS_EPS = 1e-5f;
constexpr size_t SZ_ACT = (size_t)TP * 1024 * 2;
constexpr size_t WS_XB = 0;
constexpr size_t WS_YD = WS_XB;
constexpr size_t WS_UG = WS_XB + SZ_ACT, WS_VG = WS_UG + SZ_ACT, WS_Z = WS_VG + SZ_ACT, WS_XBC = WS_Z + SZ_ACT;
constexpr size_t WS_H = WS_UG;
constexpr size_t WS_MIX = WS_XBC + (size_t)TP * XW * 2;
constexpr size_t WS_DT = WS_MIX + (size_t)TP * MIXW * 2;
constexpr size_t WS_ACUM = WS_DT + (size_t)TP * 16 * 4;
constexpr size_t WS_VST = WS_ACUM + (size_t)TP * 16 * 4;
constexpr size_t WS_CN = WS_VST + (size_t)TP * 16 * 8;
constexpr int NST = 2048 + 128;
constexpr size_t WS_ST = WS_CN + (size_t)TP * 256 * 2;
constexpr size_t WS_DEC = WS_ST + (size_t)NST * 8192 * 2;
constexpr size_t WS_WOUT = WS_DEC + 16384;
constexpr size_t WS_WF1 = WS_WOUT + (size_t)1024 * 2048 * 2;
constexpr size_t WS_WIN = WS_WF1;
constexpr size_t WS_WF2 = WS_WF1 + (size_t)NINP * 1024 * 2;
constexpr size_t WS_GW = WS_WF2 + (size_t)4096 * 1024 * 2;
constexpr size_t WS_BAR = WS_GW + (size_t)DEPTH * 8 * 128 * 128 * 2;
constexpr size_t WS_END = WS_BAR + 256;
static_assert(WS_XBC + (size_t)TP * XW * 2 - WS_UG >= (size_t)TP * DFF * 2, "H alias");
static_assert(WS_END <= (size_t)330883840, "workspace");
constexpr size_t O_YP = 0, O_YS = 16777216, O_SSMP = 16908288, O_CONVP = 21102592, O_SSMS = 21250048, O_CONVS = 25444352, O_VS = 25591808;
constexpr int LDS_BYTES = 135168;

struct Params {
  const float* in[22]; float* out; unsigned char* ws; int ph_lo, ph_hi;
};
struct InProxy { const Params& p; int z; __device__ __forceinline__ const float* operator[](int k) const { return p.in[k + z]; } };
struct Lp { InProxy in; unsigned char* ws; float* out; int tid, bid, G; };

__device__ __forceinline__ float bf2f(unsigned short b) { return __uint_as_float(((unsigned)b) << 16); }
__device__ __forceinline__ float lo2f(unsigned w) { return __uint_as_float(w << 16); }
__device__ __forceinline__ float hi2f(unsigned w) { return __uint_as_float(w & 0xffff0000u); }
__device__ __forceinline__ unsigned short f2bf(float f) { return (unsigned short)(cvt_pk_bf16(f, 0.f) & 0xffffu); }
__device__ __forceinline__ float gelu_t(float x) { const float u = 0.7978845608f * (x + 0.044715f * x * x * x); return x * __builtin_amdgcn_rcpf(1.0f + __builtin_amdgcn_exp2f(-2.885390082f * u)); }
__device__ __forceinline__ float silu_f(float x) { return x * __builtin_amdgcn_rcpf(1.0f + __builtin_amdgcn_exp2f(-1.442695041f * x)); }
__device__ __forceinline__ float exp_f(float x) { return __builtin_amdgcn_exp2f(1.442695041f * x); }
__device__ __forceinline__ float softplus_f(float x) { return x > 20.f ? x : log1pf(__expf(x)); }
__device__ __forceinline__ void unpack8(const u32x4 w, float (&f)[8]) { f[0] = lo2f(w.x); f[1] = hi2f(w.x); f[2] = lo2f(w.y); f[3] = hi2f(w.y); f[4] = lo2f(w.z); f[5] = hi2f(w.z); f[6] = lo2f(w.w); f[7] = hi2f(w.w); }

struct EpiIn {
  static constexpr bool PERM = true, AFTER_DRAIN = false;
  bf16_t *UG, *VG, *Z, *XBC; float* DT; f32x2* VST;
  __device__ __forceinline__ void operator()(const f32x4 (&acc)[2][2][4][2], const Unit& u, int wr, int wc, int fr, int fq) const {
    const int row0 = u.pm * 256 + wr * 64 + fr; const int pn = u.pn;
    if (pn < 18) {
      bf16_t* base; int ld, colt;
      if (pn < 4) { base = UG; ld = 1024; colt = pn * 256; } else if (pn < 8) { base = VG; ld = 1024; colt = (pn - 4) * 256; }
      else if (pn < 12) { base = Z; ld = 1024; colt = (pn - 8) * 256; } else { base = XBC; ld = XW; colt = (pn - 12) * 256; }
      const int col0 = colt + wc * 32 + 8 * fq; const bool act = pn < 8;
#pragma unroll
      for (int ai = 0; ai < 2; ++ai)
#pragma unroll
        for (int m = 0; m < 4; ++m) { bf16_t* rowp = base + (size_t)(row0 + ai * 128 + m * 16) * ld + col0; float rs = 0.f, rq = 0.f;
#pragma unroll
          for (int bj = 0; bj < 2; ++bj) { f32x4 v0 = acc[ai][bj][m][0], v1 = acc[ai][bj][m][1];
            if (act) {
#pragma unroll
              for (int j = 0; j < 4; ++j) { v0[j] = gelu_t(v0[j]); v1[j] = gelu_t(v1[j]); } }
            if (act) {
#pragma unroll
              for (int j = 0; j < 4; ++j) { rs += v0[j] + v1[j]; rq += v0[j] * v0[j] + v1[j] * v1[j]; } }
            u32x4 w; w.x = cvt_pk_bf16(v0[0], v0[1]); w.y = cvt_pk_bf16(v0[2], v0[3]); w.z = cvt_pk_bf16(v1[0], v1[1]); w.w = cvt_pk_bf16(v1[2], v1[3]);
            *(u32x4*)(rowp + bj * 128) = w; }
          if (pn >= 4 && pn < 8) { rs += __shfl_xor(rs, 16); rs += __shfl_xor(rs, 32); rq += __shfl_xor(rq, 16); rq += __shfl_xor(rq, 32);
            if (fq == 0) VST[(size_t)(row0 + ai * 128 + m * 16) * 16 + (pn - 4) * 4 + wc] = (f32x2){rs, rq}; } }
    } else if (wc == 0 && fq < 2) {
#pragma unroll
      for (int ai = 0; ai < 2; ++ai)
#pragma unroll
        for (int m = 0; m < 4; ++m) { float* p = DT + (size_t)(row0 + ai * 128 + m * 16) * 16 + 8 * fq; *(f32x4*)p = acc[ai][0][m][0]; *(f32x4*)(p + 4) = acc[ai][0][m][1]; }
    }
  }
};
struct EpiRes {
  static constexpr bool PERM = false, AFTER_DRAIN = false;
  float* X;
  __device__ __forceinline__ void operator()(const f32x4 (&acc)[2][2][4][2], const Unit& u, int wr, int wc, int fr, int fq) const {
    const int row0 = u.pm * 256 + wr * 64 + fr, col0 = u.pn * 256 + wc * 32 + 4 * fq;
#pragma unroll
    for (int ai = 0; ai < 2; ++ai)
#pragma unroll
      for (int m = 0; m < 4; ++m) { const int row = row0 + ai * 128 + m * 16;
        if (row < T) { float* rowp = X + (size_t)row * 1024 + col0;
#pragma unroll
          for (int bj = 0; bj < 2; ++bj)
#pragma unroll
            for (int n = 0; n < 2; ++n) { f32x4 x = *(const f32x4*)(rowp + bj * 128 + n * 16); *(f32x4*)(rowp + bj * 128 + n * 16) = x * ALPHA + acc[ai][bj][m][n]; } } }
  }
};
struct EpiRelu2 {
  static constexpr bool PERM = true, AFTER_DRAIN = false;
  bf16_t* H;
  __device__ __forceinline__ void operator()(const f32x4 (&acc)[2][2][4][2], const Unit& u, int wr, int wc, int fr, int fq) const {
    const int row0 = u.pm * 256 + wr * 64 + fr, col0 = u.pn * 256 + wc * 32 + 8 * fq;
#pragma unroll
    for (int ai = 0; ai < 2; ++ai)
#pragma unroll
      for (int m = 0; m < 4; ++m) { bf16_t* rowp = H + (size_t)(row0 + ai * 128 + m * 16) * DFF + col0;
#pragma unroll
        for (int bj = 0; bj < 2; ++bj) { f32x4 v0 = acc[ai][bj][m][0], v1 = acc[ai][bj][m][1];
#pragma unroll
          for (int j = 0; j < 4; ++j) { const float a = fmaxf(v0[j], 0.f), b = fmaxf(v1[j], 0.f); v0[j] = a * a; v1[j] = b * b; }
          u32x4 w; w.x = cvt_pk_bf16(v0[0], v0[1]); w.y = cvt_pk_bf16(v0[2], v0[3]); w.z = cvt_pk_bf16(v1[0], v1[1]); w.w = cvt_pk_bf16(v1[2], v1[3]);
          *(u32x4*)(rowp + bj * 128) = w; } }
  }
};

struct CvtJob { const float* W; bf16_t* Wt; int K, N, ntn, ntiles; };
__device__ __forceinline__ void cvt_run(LAS unsigned char* lds, const CvtJob& j0, const CvtJob& j1, const CvtJob& j2, int j, int nw) {
  LAS float* tl = (LAS float*)lds; int tid_ = threadIdx.x; asm volatile("" : "+v"(tid_)); const int tid = tid_;
  const int e0 = j0.ntiles, e1 = e0 + j1.ntiles, e2 = e1 + j2.ntiles;
  for (int t0 = j * 4; t0 < e2; t0 += nw * 4) {
    f32x4 v[4][2];
#pragma unroll
    for (int u = 0; u < 4; ++u) { const int t = t0 + u < e2 ? t0 + u : e2 - 1;
      const CvtJob& J = t < e0 ? j0 : (t < e1 ? j1 : j2); const int tt = t < e0 ? t : (t < e1 ? t - e0 : t - e1); const int kt = tt / J.ntn, nt = tt - kt * J.ntn, k0 = kt * 64, n0 = nt * 64; int nn = (tid & 15) * 4;
      const bool inr = n0 + nn < J.N; if (!inr) nn = 0;
      const float* src = J.W + (size_t)(k0 + (tid >> 4)) * J.N + (inr ? n0 + nn : 0);
      v[u][0] = *(const f32x4*)src; v[u][1] = *(const f32x4*)(src + (size_t)32 * J.N);
      if (!inr) { v[u][0] = (f32x4){0.f, 0.f, 0.f, 0.f}; v[u][1] = v[u][0]; } }
#pragma unroll
    for (int u = 0; u < 4; ++u)
#pragma unroll
      for (int it = 0; it < 2; ++it) { LAS float* d = tl + u * 4160 + ((tid >> 4) + it * 32) * 65 + (tid & 15) * 4; d[0] = v[u][it][0]; d[1] = v[u][it][1]; d[2] = v[u][it][2]; d[3] = v[u][it][3]; }
    __syncthreads();
#pragma unroll
    for (int u = 0; u < 4; ++u) { const int t = t0 + u;
      if (t < e2) { const CvtJob& J = t < e0 ? j0 : (t < e1 ? j1 : j2); const int tt = t < e0 ? t : (t < e1 ? t - e0 : t - e1); const int kt = tt / J.ntn, nt = tt - kt * J.ntn, k0 = kt * 64, n0 = nt * 64;
        const int nn = tid >> 3, kk = (tid & 7) * 8; float f[8];
#pragma unroll
        for (int i = 0; i < 8; ++i) f[i] = tl[u * 4160 + (kk + i) * 65 + nn];
        u32x4 w; w.x = cvt_pk_bf16(f[0], f[1]); w.y = cvt_pk_bf16(f[2], f[3]); w.z = cvt_pk_bf16(f[4], f[5]); w.w = cvt_pk_bf16(f[6], f[7]);
        *(u32x4*)(J.Wt + (size_t)(n0 + nn) * J.K + k0 + kk) = w; } }
    __syncthreads();
  }
}
template <int R4> __device__ __forceinline__ bf16x8 tr_frag(unsigned addr) {
  u32x2 lo, hi; asm volatile("ds_read_b64_tr_b16 %0, %2\n\tds_read_b64_tr_b16 %1, %2 offset:%3\n\ts_waitcnt lgkmcnt(0)" : "=&v"(lo), "=&v"(hi) : "v"(addr), "n"(R4) : "memory");
  u32x4 r; r.x = lo.x; r.y = lo.y; r.z = hi.x; r.w = hi.y; return __builtin_bit_cast(bf16x8, r);
}

template <int R4> __device__ __forceinline__ void tr_frag4(unsigned a0, unsigned a1, unsigned a2, unsigned a3, bf16x8 (&out)[4]) {
  u32x2 l0, h0, l1, h1, l2, h2, l3, h3;
  asm volatile("ds_read_b64_tr_b16 %0, %8\n\tds_read_b64_tr_b16 %1, %8 offset:%12\n\tds_read_b64_tr_b16 %2, %9\n\tds_read_b64_tr_b16 %3, %9 offset:%12\n\t"
               "ds_read_b64_tr_b16 %4, %10\n\tds_read_b64_tr_b16 %5, %10 offset:%12\n\tds_read_b64_tr_b16 %6, %11\n\tds_read_b64_tr_b16 %7, %11 offset:%12\n\ts_waitcnt lgkmcnt(0)"
               : "=&v"(l0), "=&v"(h0), "=&v"(l1), "=&v"(h1), "=&v"(l2), "=&v"(h2), "=&v"(l3), "=&v"(h3) : "v"(a0), "v"(a1), "v"(a2), "v"(a3), "n"(R4) : "memory");
  u32x4 r; r.x = l0.x; r.y = l0.y; r.z = h0.x; r.w = h0.y; out[0] = __builtin_bit_cast(bf16x8, r); r.x = l1.x; r.y = l1.y; r.z = h1.x; r.w = h1.y; out[1] = __builtin_bit_cast(bf16x8, r);
  r.x = l2.x; r.y = l2.y; r.z = h2.x; r.w = h2.y; out[2] = __builtin_bit_cast(bf16x8, r); r.x = l3.x; r.y = l3.y; r.z = h3.x; r.w = h3.y; out[3] = __builtin_bit_cast(bf16x8, r);
}

constexpr int PT = 136;
__device__ __forceinline__ void gmlp_item(LAS unsigned char* lds, const Lp& p, int l, int rowbase, int nrows, int h, float* vout  ) {
  int tid_ = threadIdx.x; asm volatile("" : "+v"(tid_)); const int tid = tid_, wid = __builtin_amdgcn_readfirstlane(tid >> 6), lane = tid & 63, fr = lane & 15, fq = lane >> 4;
  const bf16_t* VG = (const bf16_t*)(p.ws + WS_VG); const bf16_t* UG = (const bf16_t*)(p.ws + WS_UG); bf16_t* MIX = (bf16_t*)(p.ws + WS_MIX);
  const bf16_t* GW = (const bf16_t*)(p.ws + WS_GW) + (size_t)(l * 8 + h) * 128 * 128;
  LAS bf16_t* vimg = (LAS bf16_t*)lds; LAS f32x2* st = (LAS f32x2*)(lds + 128 * PT * 2);
  if (tid < 128) { float mean = 0.f, rstd = 0.f;
    if (tid < nrows) { const f32x4* q = (const f32x4*)(p.ws + WS_VST + (size_t)(rowbase + tid) * 128); float s = 0.f, ss = 0.f;
#pragma unroll
      for (int i = 0; i < 8; ++i) { const f32x4 v = q[i]; s += v[0] + v[2]; ss += v[1] + v[3]; }
      mean = s * (1.0f / 1024.0f); rstd = rsqrtf(fmaxf(ss * (1.0f / 1024.0f) - mean * mean, 0.f) + LN_EPS); }
    st[tid] = (f32x2){mean, rstd}; }
  __syncthreads();
  { const int s = tid >> 2, cg0 = (tid & 3) * 32; const f32x2 ms = st[s]; const float* G = p.in[5] + l * 1024 + h * 128 + cg0; const float* Bb = p.in[6] + l * 1024 + h * 128 + cg0;
#pragma unroll
    for (int i = 0; i < 4; ++i) { float f[8];
      if (s < nrows) { unpack8(*(const u32x4*)(VG + (size_t)(rowbase + s) * 1024 + h * 128 + cg0 + 8 * i), f);
#pragma unroll
        for (int e = 0; e < 8; ++e) f[e] = (f[e] - ms.x) * ms.y * G[8 * i + e] + Bb[8 * i + e];
        if (vout) { float* o = vout + (size_t)s * 1024 + h * 128 + cg0 + 8 * i; *(f32x4*)o = (f32x4){f[0], f[1], f[2], f[3]}; *(f32x4*)(o + 4) = (f32x4){f[4], f[5], f[6], f[7]}; }
      } else {
#pragma unroll
        for (int e = 0; e < 8; ++e) f[e] = 0.f; }
      u32x4 w; w.x = cvt_pk_bf16(f[0], f[1]); w.y = cvt_pk_bf16(f[2], f[3]); w.z = cvt_pk_bf16(f[4], f[5]); w.w = cvt_pk_bf16(f[6], f[7]);
      *(LAS u32x4*)(vimg + s * PT + cg0 + 8 * i) = w; } }
  __syncthreads();
  if (wid * 16 < nrows) {
    f32x4 acc[8];
#pragma unroll
    for (int n = 0; n < 8; ++n) acc[n] = (f32x4){0.f, 0.f, 0.f, 0.f};
    const int nks = (wid * 16 + 15) / 32 + 1; const unsigned lbase = (unsigned)(size_t)lds;
    for (int ks = 0; ks < nks; ++ks) { const bf16x8 a = *(const bf16x8*)(GW + (size_t)(wid * 16 + fr) * 128 + ks * 32 + fq * 8);
#pragma unroll
      for (int n4 = 0; n4 < 2; ++n4) { bf16x8 bb[4]; const unsigned a0 = lbase + (unsigned)(((ks * 32 + fq * 8 + (fr >> 2)) * PT + n4 * 64 + 4 * (fr & 3)) * 2); tr_frag4<4 * PT * 2>(a0, a0 + 32, a0 + 64, a0 + 96, bb);
#pragma unroll
        for (int n = 0; n < 4; ++n) acc[n4 * 4 + n] = __builtin_amdgcn_mfma_f32_16x16x32_bf16(bb[n], a, acc[n4 * 4 + n], 0, 0, 0); } }
    const int t = wid * 16 + fr;
    if (t < nrows) { const float bs = p.in[8][(l * 8 + h) * 128 + t]; const size_t row = (size_t)(rowbase + t);
#pragma unroll
      for (int n = 0; n < 8; ++n) { const int col = h * 128 + n * 16 + fq * 4; const u32x2 ug = *(const u32x2*)(UG + row * 1024 + col);
        u32x2 w; w.x = cvt_pk_bf16(lo2f(ug.x) * (acc[n][0] + bs), hi2f(ug.x) * (acc[n][1] + bs)); w.y = cvt_pk_bf16(lo2f(ug.y) * (acc[n][2] + bs), hi2f(ug.y) * (acc[n][3] + bs));
        *(u32x2*)(MIX + row * MIXW + col) = w; } } }
  __syncthreads();
}
constexpr int XP = 72;
constexpr int L_BM = 0, L_CM = 128 * PT * 2, L_XH = 2 * 128 * PT * 2, L_XS = L_XH + 128 * XP * 2, L_AC = L_XS + 128 * XP * 2, L_DT = L_AC + 4096;
static_assert(L_DT + 4096 <= LDS_BYTES, "LDS");
__device__ __forceinline__ size_t st_item(int b, int c, int h, bool sample) { return sample ? (size_t)(2048 + b * 16 + h) : (size_t)((b * 16 + c) * 16 + h); }
__device__ __forceinline__ void ssd_ma_item(LAS unsigned char* lds, const Lp& p, int l, int b, int c, int g, bool sample) {
  int tid_ = threadIdx.x; asm volatile("" : "+v"(tid_)); const int tid = tid_, wid = __builtin_amdgcn_readfirstlane(tid >> 6), lane = tid & 63, fr = lane & 15, fq = lane >> 4;
  const int seq0 = sample ? TPR + b * DSEQ : b * SEQ, pos0 = c * 128, crow = seq0 + pos0, nrows = sample ? DSEQ : 128;
  const bf16_t* XBC = (const bf16_t*)(p.ws + WS_XBC); const float* DT = (const float*)(p.ws + WS_DT);
  LAS bf16_t* Bm = (LAS bf16_t*)(lds + L_BM); LAS bf16_t* Cm = (LAS bf16_t*)(lds + L_CM); LAS bf16_t* xh = (LAS bf16_t*)(lds + L_XH); LAS bf16_t* xs = (LAS bf16_t*)(lds + L_XS);
  LAS float* acum = (LAS float*)(lds + L_AC); LAS float* dtv = (LAS float*)(lds + L_DT); const unsigned lbase = (unsigned)(size_t)lds;
  const float* convw = p.in[9] + (size_t)l * 4 * XW; const float* convb = p.in[10] + (size_t)l * XW; const float* cstate = p.in[3] + (size_t)(l * 8 + b) * 3 * XW;
  { const int h = g * 8 + wid; const float av = -__expf(p.in[12][l * 16 + h]), dtb = p.in[11][l * 16 + h];
    float d0 = 0.f, d1 = 0.f; if (lane < nrows) d0 = softplus_f(DT[(size_t)(crow + lane) * 16 + h] + dtb); if (lane + 64 < nrows) d1 = softplus_f(DT[(size_t)(crow + lane + 64) * 16 + h] + dtb);
    float s0 = d0 * av, s1 = d1 * av;
#pragma unroll
    for (int o = 1; o < 64; o <<= 1) { const float t0 = __shfl_up(s0, o), t1 = __shfl_up(s1, o); if (lane >= o) { s0 += t0; s1 += t1; } }
    s1 += __shfl(s0, 63);
    acum[wid * 128 + lane] = s0; acum[wid * 128 + 64 + lane] = s1; dtv[wid * 128 + lane] = d0; dtv[wid * 128 + 64 + lane] = d1;
    float* AC = (float*)(p.ws + WS_ACUM); if (lane < nrows) AC[(size_t)(crow + lane) * 16 + h] = s0; if (lane + 64 < nrows) AC[(size_t)(crow + lane + 64) * 16 + h] = s1;
    if (lane == 63) ((float*)(p.ws + WS_DEC))[st_item(b, c, h, sample)] = exp_f(s1); }
  { const int cgi = tid & 31, rr = tid >> 5; const int nn = (cgi & 15) * 8, ch = (cgi < 16 ? 1024 : 1280) + g * 128 + nn; const int j0 = rr * 8;
    float w0[8], w1[8], w2[8], w3[8], bb[8], p0[8], p1[8], p2[8];
#pragma unroll
    for (int e = 0; e < 8; ++e) { w0[e] = convw[ch + e]; w1[e] = convw[XW + ch + e]; w2[e] = convw[2 * XW + ch + e]; w3[e] = convw[3 * XW + ch + e]; bb[e] = convb[ch + e]; }
#pragma unroll
    for (int i = 0; i < 3; ++i) { const int pos = pos0 + j0 - 3 + i; float f[8];
      if (pos >= 0) unpack8(*(const u32x4*)(XBC + (size_t)(seq0 + pos) * XW + ch), f);
      else {
#pragma unroll
        for (int e = 0; e < 8; ++e) f[e] = sample ? cstate[(3 + pos) * XW + ch + e] : 0.f; }
#pragma unroll
      for (int e = 0; e < 8; ++e) { if (i == 0) p0[e] = f[e]; else if (i == 1) p1[e] = f[e]; else p2[e] = f[e]; } }
    bf16_t* CN = (bf16_t*)(p.ws + WS_CN);
#pragma unroll
    for (int jj = 0; jj < 8; ++jj) { const int j = j0 + jj; float cur[8], o[8]; unpack8(*(const u32x4*)(XBC + (size_t)(crow + j) * XW + ch), cur);
#pragma unroll
      for (int e = 0; e < 8; ++e) { const float v = bb[e] + w0[e] * p0[e] + w1[e] * p1[e] + w2[e] * p2[e] + w3[e] * cur[e]; o[e] = (j < nrows) ? silu_f(v) : 0.f; p0[e] = p1[e]; p1[e] = p2[e]; p2[e] = cur[e]; }
      u32x4 w; w.x = cvt_pk_bf16(o[0], o[1]); w.y = cvt_pk_bf16(o[2], o[3]); w.z = cvt_pk_bf16(o[4], o[5]); w.w = cvt_pk_bf16(o[6], o[7]);
      if (cgi < 16) *(LAS u32x4*)(Bm + j * PT + nn) = w; else { *(LAS u32x4*)(Cm + j * PT + nn) = w; if (j < nrows) *(u32x4*)(CN + (size_t)(crow + j) * 256 + g * 128 + nn) = w; } } }
  __syncthreads();
  f32x4 cb[8];
#pragma unroll
  for (int jt = 0; jt < 8; ++jt) cb[jt] = (f32x4){0.f, 0.f, 0.f, 0.f};
#pragma unroll
  for (int ks = 0; ks < 4; ++ks) { const bf16x8 bq = *(const LAS bf16x8*)(Cm + (wid * 16 + fr) * PT + ks * 32 + fq * 8);
#pragma unroll
    for (int jt = 0; jt < 8; ++jt) if (jt <= wid) { const bf16x8 a = *(const LAS bf16x8*)(Bm + (jt * 16 + fr) * PT + ks * 32 + fq * 8); cb[jt] = __builtin_amdgcn_mfma_f32_16x16x32_bf16(a, bq, cb[jt], 0, 0, 0); } }
  __syncthreads();
  LAS bf16_t* Pm = Cm;
  bf16_t* YD = (bf16_t*)(p.ws + WS_YD); bf16_t* ST = (bf16_t*)(p.ws + WS_ST);
  for (int h8 = 0; h8 < 8; ++h8) { const int h = g * 8 + h8; const float Dh = p.in[13][l * 16 + h]; const float alast = acum[h8 * 128 + 127];
    { const int cgi = tid & 7, rr = tid >> 3; const int nn = cgi * 8, ch = h * 64 + nn, j0 = rr * 2; float w0[8], w1[8], w2[8], w3[8], bb[8], r[5][8];
#pragma unroll
      for (int e = 0; e < 8; ++e) { w0[e] = convw[ch + e]; w1[e] = convw[XW + ch + e]; w2[e] = convw[2 * XW + ch + e]; w3[e] = convw[3 * XW + ch + e]; bb[e] = convb[ch + e]; }
#pragma unroll
      for (int i = 0; i < 5; ++i) { const int pos = pos0 + j0 - 3 + i;
        if (pos >= 0) unpack8(*(const u32x4*)(XBC + (size_t)(seq0 + pos) * XW + ch), r[i]);
        else {
#pragma unroll
          for (int e = 0; e < 8; ++e) r[i][e] = sample ? cstate[(3 + pos) * XW + ch + e] : 0.f; } }
#pragma unroll
      for (int jj = 0; jj < 2; ++jj) { const int j = j0 + jj; float o[8], os[8]; const float wj = exp_f(alast - acum[h8 * 128 + j]) * dtv[h8 * 128 + j];
#pragma unroll
        for (int e = 0; e < 8; ++e) { const float v = bb[e] + w0[e] * r[jj][e] + w1[e] * r[jj + 1][e] + w2[e] * r[jj + 2][e] + w3[e] * r[jj + 3][e]; o[e] = (j < nrows) ? silu_f(v) : 0.f; os[e] = o[e] * wj; }
        u32x4 w; w.x = cvt_pk_bf16(o[0], o[1]); w.y = cvt_pk_bf16(o[2], o[3]); w.z = cvt_pk_bf16(o[4], o[5]); w.w = cvt_pk_bf16(o[6], o[7]); *(LAS u32x4*)(xh + j * XP + nn) = w;
        w.x = cvt_pk_bf16(os[0], os[1]); w.y = cvt_pk_bf16(os[2], os[3]); w.z = cvt_pk_bf16(os[4], os[5]); w.w = cvt_pk_bf16(os[6], os[7]); *(LAS u32x4*)(xs + j * XP + nn) = w; } }
    { const int i = wid * 16 + fr; const float ai = acum[h8 * 128 + i];
#pragma unroll
      for (int jt = 0; jt < 8; ++jt) { float v[4];
#pragma unroll
        for (int r = 0; r < 4; ++r) { const int j = jt * 16 + fq * 4 + r; float x = 0.f; if (jt <= wid && j <= i) x = cb[jt][r] * exp_f(ai - acum[h8 * 128 + j]) * dtv[h8 * 128 + j]; if (j == i) x += Dh; v[r] = x; }
        u32x2 w; w.x = cvt_pk_bf16(v[0], v[1]); w.y = cvt_pk_bf16(v[2], v[3]); *(LAS u32x2*)(Pm + i * PT + jt * 16 + fq * 4) = w; } }
    __syncthreads();
    { f32x4 y[4], hs[4];
#pragma unroll
      for (int pt = 0; pt < 4; ++pt) { y[pt] = (f32x4){0.f, 0.f, 0.f, 0.f}; hs[pt] = y[pt]; }
      const int nks = (wid * 16 + 15) / 32 + 1;
      for (int ks = 0; ks < nks; ++ks) { const bf16x8 bq = *(const LAS bf16x8*)(Pm + (wid * 16 + fr) * PT + ks * 32 + fq * 8);
        bf16x8 xa[4]; const unsigned a0 = lbase + L_XH + (unsigned)(((ks * 32 + fq * 8 + (fr >> 2)) * XP + 4 * (fr & 3)) * 2); tr_frag4<4 * XP * 2>(a0, a0 + 32, a0 + 64, a0 + 96, xa);
#pragma unroll
        for (int pt = 0; pt < 4; ++pt) y[pt] = __builtin_amdgcn_mfma_f32_16x16x32_bf16(xa[pt], bq, y[pt], 0, 0, 0); }
#pragma unroll
      for (int ks = 0; ks < 4; ++ks) { const bf16x8 a = tr_frag<4 * PT * 2>(lbase + L_BM + (unsigned)(((ks * 32 + fq * 8 + (fr >> 2)) * PT + wid * 16 + 4 * (fr & 3)) * 2));
        bf16x8 xb[4]; const unsigned a0 = lbase + L_XS + (unsigned)(((ks * 32 + fq * 8 + (fr >> 2)) * XP + 4 * (fr & 3)) * 2); tr_frag4<4 * XP * 2>(a0, a0 + 32, a0 + 64, a0 + 96, xb);
#pragma unroll
        for (int pt = 0; pt < 4; ++pt) hs[pt] = __builtin_amdgcn_mfma_f32_16x16x32_bf16(a, xb[pt], hs[pt], 0, 0, 0); }
      const int i = wid * 16 + fr; bf16_t* sti = ST + st_item(b, c, h, sample) * 8192;
#pragma unroll
      for (int pt = 0; pt < 4; ++pt) { u32x2 w;
        if (i < nrows) { w.x = cvt_pk_bf16(y[pt][0], y[pt][1]); w.y = cvt_pk_bf16(y[pt][2], y[pt][3]); *(u32x2*)(YD + (size_t)(crow + i) * 1024 + h * 64 + pt * 16 + fq * 4) = w; }
        w.x = cvt_pk_bf16(hs[pt][0], hs[pt][1]); w.y = cvt_pk_bf16(hs[pt][2], hs[pt][3]); *(u32x2*)(sti + (pt * 16 + fr) * 128 + wid * 16 + fq * 4) = w; } }
    __syncthreads();
  }
}
__device__ __forceinline__ void ssd_scan_phase(const Lp& p, int l) {
  bf16_t* ST = (bf16_t*)(p.ws + WS_ST); const float* DEC = (const float*)(p.ws + WS_DEC);
  for (int gid = p.bid * 512 + p.tid; gid < 8 * 16 * 64 * 16; gid += p.G * 512) { const int e8 = gid & 15, pp = (gid >> 4) & 63, h = (gid >> 10) & 15, b = gid >> 14; const size_t eoff = (size_t)pp * 128 + e8 * 8;
    u32x4 sv[16]; float dc[16];
#pragma unroll
    for (int c = 0; c < 16; ++c) { sv[c] = *(const u32x4*)(ST + st_item(b, c, h, false) * 8192 + eoff); dc[c] = DEC[st_item(b, c, h, false)]; }
    float hr[8];
#pragma unroll
    for (int e = 0; e < 8; ++e) hr[e] = 0.f;
#pragma unroll
    for (int c = 0; c < 16; ++c) { u32x4 w; w.x = cvt_pk_bf16(hr[0], hr[1]); w.y = cvt_pk_bf16(hr[2], hr[3]); w.z = cvt_pk_bf16(hr[4], hr[5]); w.w = cvt_pk_bf16(hr[6], hr[7]);
      *(u32x4*)(ST + st_item(b, c, h, false) * 8192 + eoff) = w; float f[8]; unpack8(sv[c], f);
#pragma unroll
      for (int e = 0; e < 8; ++e) hr[e] = dc[c] * hr[e] + f[e]; }
    { float* o = p.out + O_SSMP + (size_t)((l * 8 + b) * 16 + h) * 8192 + eoff; *(f32x4*)o = (f32x4){hr[0], hr[1], hr[2], hr[3]}; *(f32x4*)(o + 4) = (f32x4){hr[4], hr[5], hr[6], hr[7]}; }
    { const float* h0 = p.in[2] + (size_t)((l * 8 + b) * 16 + h) * 8192 + eoff; const f32x4 a = *(const f32x4*)h0, bq = *(const f32x4*)(h0 + 4); bf16_t* sp = ST + st_item(b, 0, h, true) * 8192 + eoff;
      float f[8]; unpack8(*(const u32x4*)sp, f); const float d = DEC[st_item(b, 0, h, true)];
      u32x4 w; w.x = cvt_pk_bf16(a[0], a[1]); w.y = cvt_pk_bf16(a[2], a[3]); w.z = cvt_pk_bf16(bq[0], bq[1]); w.w = cvt_pk_bf16(bq[2], bq[3]); *(u32x4*)sp = w;
      float* o = p.out + O_SSMS + (size_t)((l * 8 + b) * 16 + h) * 8192 + eoff;
      *(f32x4*)o = (f32x4){d * a[0] + f[0], d * a[1] + f[1], d * a[2] + f[2], d * a[3] + f[3]}; *(f32x4*)(o + 4) = (f32x4){d * bq[0] + f[4], d * bq[1] + f[5], d * bq[2] + f[6], d * bq[3] + f[7]}; }
  }
}
__device__ __forceinline__ void ssd_mc_item(LAS unsigned char* lds, const Lp& p, int l, int b, int c, int g, bool sample) {
  int tid_ = threadIdx.x; asm volatile("" : "+v"(tid_)); const int tid = tid_, wid = __builtin_amdgcn_readfirstlane(tid >> 6), lane = tid & 63, fr = lane & 15, fq = lane >> 4;
  const int crow = (sample ? TPR + b * DSEQ : b * SEQ) + c * 128, nrows = sample ? DSEQ : 128; const int i = wid * 16 + fr; const size_t row = (size_t)(crow + i); const bool ok = i < nrows, wok = wid * 16 < nrows;
  const bf16_t* CN = (const bf16_t*)(p.ws + WS_CN); const bf16_t* ST = (const bf16_t*)(p.ws + WS_ST); const bf16_t* YD = (const bf16_t*)(p.ws + WS_YD); const bf16_t* Z = (const bf16_t*)(p.ws + WS_Z);
  const float* AC = (const float*)(p.ws + WS_ACUM); bf16_t* MIX = (bf16_t*)(p.ws + WS_MIX); LAS bf16_t* hl = (LAS bf16_t*)lds;
  bf16x8 cf[4];
#pragma unroll
  for (int ks = 0; ks < 4; ++ks) cf[ks] = *(const bf16x8*)(CN + row * 256 + g * 128 + ks * 32 + fq * 8);
  float ss = 0.f;
#pragma unroll 1
  for (int r = 0; r < 2; ++r) {
    { u32x4 v[8];
#pragma unroll
      for (int q = 0; q < 8; ++q) { const int ch = tid + q * 512, hd = ch >> 10, wch = ch & 1023; v[q] = *(const u32x4*)(ST + st_item(b, c, g * 8 + r * 4 + hd, sample) * 8192 + wch * 8); }
#pragma unroll
      for (int q = 0; q < 8; ++q) { const int ch = tid + q * 512, hd = ch >> 10, wch = ch & 1023; *(LAS u32x4*)(hl + (hd * 64 + (wch >> 4)) * PT + (wch & 15) * 8) = v[q]; } }
    __syncthreads();
    if (wok) {
#pragma unroll
      for (int hd = 0; hd < 4; ++hd) { const int h = g * 8 + r * 4 + hd; f32x4 yy[4];
#pragma unroll
        for (int pt = 0; pt < 4; ++pt) yy[pt] = (f32x4){0.f, 0.f, 0.f, 0.f};
#pragma unroll
        for (int ks = 0; ks < 4; ++ks)
#pragma unroll
          for (int pt = 0; pt < 4; ++pt) { const bf16x8 a = *(const LAS bf16x8*)(hl + (hd * 64 + pt * 16 + fr) * PT + ks * 32 + fq * 8); yy[pt] = __builtin_amdgcn_mfma_f32_16x16x32_bf16(a, cf[ks], yy[pt], 0, 0, 0); }
        const float ei = ok ? exp_f(AC[row * 16 + h]) : 0.f;
#pragma unroll
        for (int pt = 0; pt < 4; ++pt) { const int col = h * 64 + pt * 16 + fq * 4; u32x2 yd = {0u, 0u}, zz = {0u, 0u}; if (ok) { yd = *(const u32x2*)(YD + row * 1024 + col); zz = *(const u32x2*)(Z + row * 1024 + col); }
          f32x4 v = yy[pt] * ei; v[0] = (v[0] + lo2f(yd.x)) * silu_f(lo2f(zz.x)); v[1] = (v[1] + hi2f(yd.x)) * silu_f(hi2f(zz.x)); v[2] = (v[2] + lo2f(yd.y)) * silu_f(lo2f(zz.y)); v[3] = (v[3] + hi2f(yd.y)) * silu_f(hi2f(zz.y));
          if (ok) { ss += (v[0] * v[0] + v[1] * v[1]) + (v[2] * v[2] + v[3] * v[3]); u32x2 w; w.x = cvt_pk_bf16(v[0], v[1]); w.y = cvt_pk_bf16(v[2], v[3]); *(u32x2*)(MIX + row * MIXW + 1024 + col) = w; } } } }
    __syncthreads();
  }
  ss += __shfl_xor(ss, 16); ss += __shfl_xor(ss, 32);
  const float rstd = rsqrtf(ss * (1.0f / 512.0f) + RMS_EPS); const float* gm = p.in[14] + l * 1024 + g * 512;
  if (ok) {
#pragma unroll 8
    for (int q = 0; q < 32; ++q) { const int cc = (q >> 2) * 64 + (q & 3) * 16 + fq * 4; u32x2* ptr = (u32x2*)(MIX + row * MIXW + 1024 + g * 512 + cc); const u32x2 w0 = *ptr; const f32x4 gv = *(const f32x4*)(gm + cc);
      u32x2 w; w.x = cvt_pk_bf16(lo2f(w0.x) * rstd * gv[0], hi2f(w0.x) * rstd * gv[1]); w.y = cvt_pk_bf16(lo2f(w0.y) * rstd * gv[2], hi2f(w0.y) * rstd * gv[3]); *ptr = w; } }
}
template <int NT, int KIND> __device__ __forceinline__ void skinny_task(LAS unsigned char* lds, const Lp& p, const bf16_t* __restrict__ A, const bf16_t* __restrict__ Bt, int K, int rb, int cb) {
  int tid_ = threadIdx.x; asm volatile("" : "+v"(tid_)); const int tid = tid_, wid = __builtin_amdgcn_readfirstlane(tid >> 6), lane = tid & 63, fr = lane & 15, fq = lane >> 4;
  const int rt = wid & 1, ksp = wid >> 1, Kw = K >> 2, row = TPR + rb * 32 + rt * 16 + fr;
  const bf16_t* ap = A + (size_t)row * K + ksp * Kw + fq * 8; const bf16_t* bp = Bt + (size_t)(cb * 16 * NT + fr) * K + ksp * Kw + fq * 8;
  f32x4 acc[NT];
#pragma unroll
  for (int n = 0; n < NT; ++n) acc[n] = (f32x4){0.f, 0.f, 0.f, 0.f};
#pragma unroll 4
  for (int ks = 0; ks < (Kw >> 5); ++ks) { const bf16x8 a = *(const bf16x8*)(ap + ks * 32);
#pragma unroll
    for (int n = 0; n < NT; ++n) { const bf16x8 b = *(const bf16x8*)(bp + (size_t)n * 16 * K + ks * 32); acc[n] = __builtin_amdgcn_mfma_f32_16x16x32_bf16(b, a, acc[n], 0, 0, 0); } }
  LAS f32x4* red = (LAS f32x4*)lds;
  if (ksp > 0) {
#pragma unroll
    for (int n = 0; n < NT; ++n) red[(((ksp - 1) * 2 + rt) * NT + n) * 64 + lane] = acc[n]; }
  __syncthreads();
  if (ksp == 0) {
    float rs = 0.f, rq = 0.f; const int col0 = cb * 16 * NT + fq * 4;
#pragma unroll
    for (int n = 0; n < NT; ++n) { f32x4 v = acc[n];
#pragma unroll
      for (int s = 0; s < 3; ++s) v += red[((s * 2 + rt) * NT + n) * 64 + lane];
      const int col = col0 + n * 16;
      if (KIND == 1) { float* x = p.out + (size_t)row * 1024 + col; *(f32x4*)x = *(const f32x4*)x * ALPHA + v; }
      else if (KIND == 2) { u32x2 w; const float a0 = fmaxf(v[0], 0.f), a1 = fmaxf(v[1], 0.f), a2 = fmaxf(v[2], 0.f), a3 = fmaxf(v[3], 0.f); w.x = cvt_pk_bf16(a0 * a0, a1 * a1); w.y = cvt_pk_bf16(a2 * a2, a3 * a3);
        *(u32x2*)((bf16_t*)(p.ws + WS_H) + (size_t)row * DFF + col) = w; }
      else {
        if (col < 2048) {
#pragma unroll
          for (int j = 0; j < 4; ++j) { v[j] = gelu_t(v[j]); rs += v[j]; rq += v[j] * v[j]; } }
        u32x2 w; w.x = cvt_pk_bf16(v[0], v[1]); w.y = cvt_pk_bf16(v[2], v[3]);
        if (col < 3072) *(u32x2*)((bf16_t*)(p.ws + (col < 1024 ? WS_UG : (col < 2048 ? WS_VG : WS_Z))) + (size_t)row * 1024 + (col & 1023)) = w;
        else if (col < 4608) *(u32x2*)((bf16_t*)(p.ws + WS_XBC) + (size_t)row * XW + (col - 3072)) = w;
        else if (col < 4624) *(f32x4*)((float*)(p.ws + WS_DT) + (size_t)row * 16 + (col - 4608)) = v; } }
    if (KIND == 0 && NT == 4) { const int cbk = cb - 16;
      rs += __shfl_xor(rs, 16); rs += __shfl_xor(rs, 32); rq += __shfl_xor(rq, 16); rq += __shfl_xor(rq, 32);
      if (cbk >= 0 && cbk < 16 && fq == 0) ((f32x2*)(p.ws + WS_VST))[(size_t)row * 16 + cbk] = (f32x2){rs, rq}; } }
  __syncthreads();
}
__device__ __forceinline__ void ln_phase(const Lp& p, const float* __restrict__ g, const float* __restrict__ b, float* Xo, bf16_t* Xb) {
  const int tid = p.tid, wid = tid >> 6, lane = tid & 63; const float* X = p.out;
  f32x4 gv[4], bv[4];
#pragma unroll
  for (int i = 0; i < 4; ++i) { gv[i] = *(const f32x4*)(g + i * 256 + lane * 4); bv[i] = *(const f32x4*)(b + i * 256 + lane * 4); }
  for (int row = p.bid * 8 + wid; row < T; row += p.G * 8) { f32x4 v[4]; float s = 0.f;
#pragma unroll
    for (int i = 0; i < 4; ++i) { v[i] = *(const f32x4*)(X + (size_t)row * 1024 + i * 256 + lane * 4); s += (v[i][0] + v[i][1]) + (v[i][2] + v[i][3]); }
#pragma unroll
    for (int o = 32; o >= 1; o >>= 1) s += __shfl_xor(s, o);
    const float mean = s * (1.0f / 1024.0f); float q = 0.f;
#pragma unroll
    for (int i = 0; i < 4; ++i) { const f32x4 d = v[i] - mean; q += (d[0] * d[0] + d[1] * d[1]) + (d[2] * d[2] + d[3] * d[3]); }
#pragma unroll
    for (int o = 32; o >= 1; o >>= 1) q += __shfl_xor(q, o);
    const float rstd = rsqrtf(q * (1.0f / 1024.0f) + LN_EPS);
#pragma unroll
    for (int i = 0; i < 4; ++i) { const f32x4 y = (v[i] - mean) * rstd * gv[i] + bv[i]; *(f32x4*)(Xo + (size_t)row * 1024 + i * 256 + lane * 4) = y;
      u32x2 w; w.x = cvt_pk_bf16(y[0], y[1]); w.y = cvt_pk_bf16(y[2], y[3]); *(u32x2*)(Xb + (size_t)row * 1024 + i * 256 + lane * 4) = w; } }
}
__device__ __forceinline__ void grid_bar(unsigned* cnt, unsigned target) {
  __syncthreads();
  if (threadIdx.x == 0) {
    __builtin_amdgcn_fence(__ATOMIC_RELEASE, "agent");
    __hip_atomic_fetch_add(cnt, 1u, __ATOMIC_RELAXED, __HIP_MEMORY_SCOPE_AGENT);
    while (__hip_atomic_load(cnt, __ATOMIC_RELAXED, __HIP_MEMORY_SCOPE_AGENT) < target) __builtin_amdgcn_s_sleep(1);
    __builtin_amdgcn_fence(__ATOMIC_ACQUIRE, "agent");
  }
  __syncthreads();
}
constexpr int NK = 9, NPH = 1 + NK * DEPTH;
__device__ __forceinline__ void p0_phase(LAS unsigned char* lds, const Lp& p) {
  const int tid = p.tid, bid = p.bid, G = p.G; bf16_t* Xb = (bf16_t*)(p.ws + WS_XB); bf16_t* GW = (bf16_t*)(p.ws + WS_GW);
  for (size_t i = (size_t)bid * 512 + tid; i < (size_t)TP * 128; i += (size_t)G * 512) { const size_t e = i * 8; u32x4 w = {0u, 0u, 0u, 0u};
    if (e < (size_t)T * 1024) { const float* src = e < (size_t)TPR * 1024 ? p.in[0] + e : p.in[1] + (e - (size_t)TPR * 1024); const f32x4 a = *(const f32x4*)src, b = *(const f32x4*)(src + 4);
      *(f32x4*)(p.out + e) = a; *(f32x4*)(p.out + e + 4) = b; w.x = cvt_pk_bf16(a[0], a[1]); w.y = cvt_pk_bf16(a[2], a[3]); w.z = cvt_pk_bf16(b[0], b[1]); w.w = cvt_pk_bf16(b[2], b[3]); }
    *(u32x4*)(Xb + e) = w; }
  for (int i = bid * 512 + tid; i < DEPTH * 8 * 128 * 128; i += G * 512) { const int s = i & 127, t = (i >> 7) & 127; GW[i] = s <= t ? f2bf(p.in[7][i]) : (bf16_t)0; }
  if (bid == 0 && tid == 0) *(unsigned*)(p.ws + WS_BAR) = 0u;
  const CvtJob j0{p.in[4], (bf16_t*)(p.ws + WS_WIN), 1024, NIN, NINP / 64, 16 * (NINP / 64)}, jn{nullptr, nullptr, 64, 64, 1, 0};
  cvt_run(lds, j0, jn, jn, bid, G);
}
__device__ __forceinline__ void ma_phase(LAS unsigned char* lds, const Lp& p, int l) {
  const int tid = p.tid, bid = p.bid, G = p.G; const bf16_t* XBC = (const bf16_t*)(p.ws + WS_XBC);
  for (int i = bid * 512 + tid; i < 2 * 8 * 3 * XW; i += G * 512) { const int smp = i / (8 * 3 * XW), r = i - smp * (8 * 3 * XW), b = r / (3 * XW), k = (r / XW) % 3, ch = r % XW;
    const size_t row = smp ? (size_t)(TPR + b * DSEQ + DSEQ - 3 + k) : (size_t)(b * SEQ + SEQ - 3 + k);
    p.out[(smp ? O_CONVS : O_CONVP) + (size_t)l * 8 * 3 * XW + r] = bf2f(XBC[row * XW + ch]); }
  for (int it = bid; it < 272; it += G) { const bool smp = it >= 256; const int i2 = it - 256;
    ssd_ma_item(lds, p, l, smp ? i2 >> 1 : it >> 5, smp ? 0 : (it >> 1) & 15, it & 1, smp); }
  const int skip = G > 32 ? 16 : 0;
  if (bid >= skip)
    for (int it = bid - skip; it < 1024 + 64; it += G - skip) { const bool smp = it >= 1024; const int i2 = it - 1024;
      gmlp_item(lds, p, l, smp ? TPR + (i2 >> 3) * DSEQ : (it >> 7) * SEQ + ((it >> 3) & 15) * 128, smp ? DSEQ : 128, it & 7, smp ? p.out + O_VS + (size_t)((l * 8 + (i2 >> 3)) * DSEQ) * 1024 : nullptr); }
}
__device__ __forceinline__ void mc_phase(LAS unsigned char* lds, const Lp& p, int l, bool dry) {
  const int bid = p.bid, G = p.G;
  for (int it = bid; it < 272; it += G) { const bool smp = it >= 256; const int i2 = it - 256;
    ssd_mc_item(lds, p, l, smp ? i2 >> 1 : it >> 5, smp ? 0 : (it >> 1) & 15, it & 1, smp); }
  const CvtJob j0{p.in[15] + (size_t)l * 2048 * 1024, (bf16_t*)(p.ws + WS_WOUT), 2048, 1024, 16, 512}, j1{p.in[18] + (size_t)l * 1024 * 4096, (bf16_t*)(p.ws + WS_WF1), 1024, 4096, 64, 1024},
               j2{p.in[19] + (size_t)l * 4096 * 1024, (bf16_t*)(p.ws + WS_WF2), 4096, 1024, 16, 1024};
  if (!dry) cvt_run(lds, j0, j1, j2, bid, G);
}
__global__ void __launch_bounds__(512, 2) mk_fwd(Params pa) {
  extern __shared__ __attribute__((aligned(16))) unsigned char shm[];
  LAS unsigned char* lds = (LAS unsigned char*)shm;
  for (int ph = pa.ph_lo; ph < pa.ph_hi; ++ph) {
    const int l = (ph - 1) / NK, k = (ph - 1) - l * NK;
#ifndef PROBE_REP
#define PROBE_REP 0
#endif
    const int nrep = (ph > 0 && ((PROBE_REP >> k) & 1)) ? 2 : 1;
    for (int rep = 0; rep < nrep; ++rep) {
    int z; asm volatile("s_mov_b32 %0, 0" : "=s"(z));
    const Lp p{InProxy{pa, z}, pa.ws + z, pa.out + z, (int)threadIdx.x + z, (int)blockIdx.x + z, (int)gridDim.x + z};
    const bool dry = rep + 1 < nrep;
    if (ph == 0) p0_phase(lds, p);
    else if (k == 0) {
      pg8::Gemm g{(const bf16_t*)(p.ws + WS_XB), (const bf16_t*)(p.ws + WS_WIN), TPR, NINP, 1024}; pg8::StaticOrder S; S.init(TPR, NINP, p.G, p.bid);
      EpiIn E{(bf16_t*)(p.ws + WS_UG), (bf16_t*)(p.ws + WS_VG), (bf16_t*)(p.ws + WS_Z), (bf16_t*)(p.ws + WS_XBC), (float*)(p.ws + WS_DT), (f32x2*)(p.ws + WS_VST)};
      pg8::gemm_phase<EpiIn, pg8::StaticOrder, false>(lds, g, S, E, nullptr);
      { const int first = p.G == 256 ? 192 : 0;
        if (p.bid >= first) for (int t = p.bid - first; t < 4 * (NINP / 64); t += p.G - first) skinny_task<4, 0>(lds, p, (const bf16_t*)(p.ws + WS_XB), (const bf16_t*)(p.ws + WS_WIN), 1024, t & 3, t >> 2); }
    } else if (k == 1) ma_phase(lds, p, l);
    else if (k == 2) ssd_scan_phase(p, l);
    else if (k == 3) mc_phase(lds, p, l, dry);
    else if (k == 4 || k == 7) {
      pg8::Gemm g{(const bf16_t*)(p.ws + (k == 4 ? WS_MIX : WS_H)), (const bf16_t*)(p.ws + (k == 4 ? WS_WOUT : WS_WF2)), TPR, 1024, k == 4 ? MIXW : DFF}; pg8::StaticOrder S; S.init(TPR, 1024, p.G, p.bid);
      EpiRes E{dry ? (float*)(p.ws + (k == 4 ? WS_UG : WS_MIX)) : p.out};
      pg8::gemm_phase<EpiRes, pg8::StaticOrder, false>(lds, g, S, E, nullptr);
      if (!dry) for (int t = p.bid; t < 4 * 64; t += p.G) skinny_task<1, 1>(lds, p, g.A, g.Bt, g.K, t & 3, t >> 2);
    } else if (k == 6) {
      pg8::Gemm g{(const bf16_t*)(p.ws + WS_XB), (const bf16_t*)(p.ws + WS_WF1), TPR, DFF, 1024}; pg8::StaticOrder S; S.init(TPR, DFF, p.G, p.bid);
      EpiRelu2 E{(bf16_t*)(p.ws + WS_H)};
      pg8::gemm_phase<EpiRelu2, pg8::StaticOrder, false>(lds, g, S, E, nullptr);
      for (int t = p.bid; t < 4 * 64; t += p.G) skinny_task<4, 2>(lds, p, g.A, g.Bt, 1024, t & 3, t >> 2);
    } else {
      ln_phase(p, p.in[k == 5 ? 16 : 20] + l * 1024, p.in[k == 5 ? 17 : 21] + l * 1024, dry ? (float*)(p.ws + WS_UG) : p.out, (bf16_t*)(p.ws + (dry ? WS_MIX : WS_XB)));
      if (k == 8 && l + 1 < DEPTH && !dry) { const CvtJob j0{p.in[4] + (size_t)(l + 1) * 1024 * NIN, (bf16_t*)(p.ws + WS_WIN), 1024, NIN, NINP / 64, 16 * (NINP / 64)}, jn{nullptr, nullptr, 64, 64, 1, 0}; cvt_run(lds, j0, jn, jn, p.bid, p.G); }
    }
    }
    if (ph + 1 < pa.ph_hi) { if (ph == 0) cg::this_grid().sync(); else grid_bar((unsigned*)(pa.ws + WS_BAR), (unsigned)ph * gridDim.x); }
  }
}

extern "C" void kernel_launch(void* const* d_in, const int* in_sizes, int n_in, void* d_out, int out_size, void* d_ws, size_t ws_size, hipStream_t stream) {
  static int grid = 0;
  if (grid == 0) {
    if (n_in != 22 || ws_size < WS_END) { fprintf(stderr, "kernel_launch: n_in %d ws %zu (need %zu)\n", n_in, ws_size, (size_t)WS_END); grid = -1; return; }
    int dev = 0, cus = 0, per_cu = 0;
    hipGetDevice(&dev); hipDeviceGetAttribute(&cus, hipDeviceAttributeMultiprocessorCount, dev);
    if (hipFuncSetAttribute((const void*)mk_fwd, hipFuncAttributeMaxDynamicSharedMemorySize, LDS_BYTES) != hipSuccess) { fprintf(stderr, "kernel_launch: hipFuncSetAttribute failed\n"); grid = -1; return; }
    if (hipOccupancyMaxActiveBlocksPerMultiprocessor(&per_cu, (const void*)mk_fwd, 512, LDS_BYTES) != hipSuccess || per_cu < 1) { fprintf(stderr, "kernel_launch: occupancy query gave %d\n", per_cu); per_cu = 1; }
    (void)hipGetLastError();
    grid = cus * per_cu;
  }
  if (grid < 0) return;
  Params p{};
  for (int i = 0; i < 22; ++i) p.in[i] = (const float*)d_in[i];
  p.out = (float*)d_out; p.ws = (unsigned char*)d_ws;
#if defined(MK_MULTI)
  for (int i = 0; i < NPH; ++i) { p.ph_lo = i; p.ph_hi = i + 1; hipLaunchKernelGGL(mk_fwd, dim3(grid), dim3(512), LDS_BYTES, stream, p); }
#else
  p.ph_lo = 0; p.ph_hi = NPH;
  void* args[] = {&p};
  hipError_t e = hipLaunchCooperativeKernel((const void*)mk_fwd, dim3(grid), dim3(512), args, LDS_BYTES, stream);
  if (e != hipSuccess) fprintf(stderr, "cooperative launch failed: %s (grid %d)\n", hipGetErrorString(e), grid);
#endif
}
```

```cpp
#include <hip/hip_runtime.h>
#include <hip/hip_cooperative_groups.h>
#include <cstdio>
namespace cg = cooperative_groups;
namespace pg8 {
#define PG8_LAS __attribute__((address_space(3)))
typedef unsigned short bf16_t;
typedef short bf16x8 __attribute__((ext_vector_type(8)));
typedef float f32x4 __attribute__((ext_vector_type(4)));
typedef unsigned u32x4 __attribute__((ext_vector_type(4)));
constexpr int BM = 256, BK = 64, HALF = 128, HTB = HALF * BK * 2  , STAGE_BYTES = 8 * HTB, NXCD = 8, WGM = 8;

__host__ __device__ __forceinline__ int lds_byte(int r, int c) { const int st = (r >> 4) * 2 + (c >> 5), rr = r & 15, cc = c & 31, ob = rr * 64 + cc * 2; return st * 1024 + (ob ^ (((ob >> 9) & 1) << 5)); }
__host__ __device__ __forceinline__ void stage_rc(int b, int& R, int& C) { const int st = b / 1024, sb = b % 1024, swz = sb ^ (((sb >> 9) & 1) << 5); R = (st >> 1) * 16 + swz / 64; C = (st & 1) * 32 + (swz % 64) / 2; }
__host__ __device__ __forceinline__ int perm32(int rho) { const int n = rho >> 4, i = rho & 15; return 8 * (i >> 2) + 4 * n + (i & 3); }

struct Unit { int pm, pn; };
struct Gemm { const bf16_t* A; const bf16_t* Bt; int M, N, K; };

struct StaticOrder {
    int nM, nN, nwg, G, c;
    __host__ __device__ void init(int M, int N, int G_, int c_) { nM = M / BM; nN = N / BM; nwg = nM * nN; G = G_; c = c_; }
    __host__ __device__ bool next(int i, Unit& u) const {
        const long L = (long)i * G + c; if (L >= nwg) return false;
        int wgid = (int)L; { const int q = nwg / NXCD, r = nwg % NXCD, xcd = wgid % NXCD, off = wgid / NXCD; wgid = (xcd < r ? xcd * (q + 1) : r * (q + 1) + (xcd - r) * q) + off; }
        const int nig = WGM * nN, gid = wgid / nig, fm = gid * WGM, gsz = (nM - fm) < WGM ? (nM - fm) : WGM;
        u.pm = fm + ((wgid % nig) % gsz); u.pn = (wgid % nig) / gsz; return true;
    }
    __device__ __forceinline__ void a_ready(const Unit&) const {}
    __device__ __forceinline__ void done(const Unit&) const {}
};
__device__ __forceinline__ unsigned cvt_pk_bf16(float lo, float hi) { unsigned r; asm volatile("v_cvt_pk_bf16_f32 %0, %1, %2" : "=v"(r) : "v"(lo), "v"(hi)); return r; }
template <class Epi, class Sched, bool STAMP = false>
__device__ __forceinline__ void gemm_phase(PG8_LAS unsigned char* lds, const Gemm g, const Sched& S, const Epi& E, unsigned long long* stamps) {
    int tid_ = threadIdx.x; asm volatile("" : "+v"(tid_)); const int tid = tid_, wid = __builtin_amdgcn_readfirstlane(tid >> 6), lane = tid & 63, wr = wid >> 2, wc = wid & 3, fr = lane & 15, fq = lane >> 4;
    const int K = g.K, nt = K / BK;
    int ts_lo = 0, ts_hi = 0, nts = 0; const unsigned long long rt_entry = STAMP ? (unsigned long long)wall_clock64() : 0ull;
#define PG8_STAMP() do { if (STAMP && wid == 0 && nts < 64) { const unsigned long long _c = (unsigned long long)clock64(); \
        ts_lo = (lane == nts) ? (int)(unsigned)_c : ts_lo; ts_hi = (lane == nts) ? (int)(unsigned)(_c >> 32) : ts_hi; ++nts; } } while (0)
    PG8_STAMP();
    unsigned voffA[2], voffB[2];
#pragma unroll
    for (int i = 0; i < 2; ++i) { int R, C; stage_rc(tid * 16 + i * 8192, R, C); const int Rb = Epi::PERM ? ((R & ~31) + perm32(R & 31)) : R;
        voffA[i] = (unsigned)(R * K + C) * 2u; voffB[i] = (unsigned)(Rb * K + C) * 2u; }
    const size_t kstep = (size_t)(BK * 2);
    const size_t hstep = (size_t)HALF * K * 2;
    const size_t tstep = 2 * hstep;
    const unsigned ldsw = (unsigned)wid * 1024u;
    const int aoff = lds_byte(wr * 64 + fr, fq * 8), boff = lds_byte(wc * 32 + fr, fq * 8);
#define PG8_SA(b, h) (((b) * 2 + (h)) * HTB)
#define PG8_SB(b, h) ((4 + (b) * 2 + (h)) * HTB)
#define PG8_STAGE(bufoff, gbase, voff) do { _Pragma("unroll") for (int _i = 0; _i < 2; ++_i) \
        __builtin_amdgcn_global_load_lds((const unsigned*)((const char*)(gbase) + (voff)[_i]), (PG8_LAS unsigned*)(lds + (bufoff) + ldsw + _i * 8192), 16, 0, 0); } while (0)
#define PG8_LDA(dst, b, h) do { _Pragma("unroll") for (int m = 0; m < 4; ++m) _Pragma("unroll") for (int k = 0; k < 2; ++k) dst[m][k] = *(const PG8_LAS bf16x8*)(lds + PG8_SA(b, h) + aoff + m * 2048 + k * 1024); } while (0)
#define PG8_LDB(dst, b, h) do { _Pragma("unroll") for (int n = 0; n < 2; ++n) _Pragma("unroll") for (int k = 0; k < 2; ++k) dst[n][k] = *(const PG8_LAS bf16x8*)(lds + PG8_SB(b, h) + boff + n * 2048 + k * 1024); } while (0)
#define PG8_MMA(ai, bj, At, Bt) do { __builtin_amdgcn_s_setprio(1); _Pragma("unroll") for (int m = 0; m < 4; ++m) _Pragma("unroll") for (int n = 0; n < 2; ++n) _Pragma("unroll") for (int k = 0; k < 2; ++k) \
        acc[ai][bj][m][n] = __builtin_amdgcn_mfma_f32_16x16x32_bf16(Bt[n][k], At[m][k], acc[ai][bj][m][n], 0, 0, 0); __builtin_amdgcn_s_setprio(0); } while (0)
#define PG8_WAIT_V(n) asm volatile("s_waitcnt vmcnt(" #n ")" ::: "memory")
#define PG8_WAIT_L(n) asm volatile("s_waitcnt lgkmcnt(" #n ")" ::: "memory")
#define PG8_BAR __builtin_amdgcn_s_barrier()
#define PG8_SCHED __builtin_amdgcn_sched_barrier(0)
    Unit cur, nxt; int ui = 0;
    if (!S.next(0, cur)) return;
    f32x4 acc[2][2][4][2];
#pragma unroll
    for (int a = 0; a < 2; ++a)
#pragma unroll
        for (int b = 0; b < 2; ++b)
#pragma unroll
            for (int m = 0; m < 4; ++m)
#pragma unroll
                for (int n = 0; n < 2; ++n) acc[a][b][m][n] = (f32x4){0.f, 0.f, 0.f, 0.f};
    bf16x8 At[4][2], B0[2][2], B1[2][2];
    const char* cA = (const char*)g.A + (size_t)cur.pm * tstep; const char* cB = (const char*)g.Bt + (size_t)cur.pn * tstep;
    S.a_ready(cur);
    PG8_STAGE(PG8_SB(0, 0), cB, voffB); PG8_STAGE(PG8_SA(0, 0), cA, voffA); PG8_STAGE(PG8_SB(0, 1), cB + hstep, voffB); PG8_STAGE(PG8_SA(0, 1), cA + hstep, voffA);
    if (wr == 1) PG8_BAR;
    PG8_WAIT_V(4); PG8_BAR;
    PG8_STAGE(PG8_SB(1, 0), cB + kstep, voffB); PG8_STAGE(PG8_SA(1, 0), cA + kstep, voffA); PG8_STAGE(PG8_SB(1, 1), cB + hstep + kstep, voffB);
    PG8_WAIT_V(6); PG8_BAR;
    PG8_STAMP();
    for (;;) {
        const bool has_next = S.next(ui + 1, nxt);
        const char* nA = has_next ? (const char*)g.A + (size_t)nxt.pm * tstep : cA; const char* nB = has_next ? (const char*)g.Bt + (size_t)nxt.pn * tstep : cB;
        for (int t = 0; t < nt; t += 2) {
            const bool last = (t == nt - 2);
            const char* a1 = cA + (size_t)(t + 1) * kstep;
            const char* a2 = last ? nA : cA + (size_t)(t + 2) * kstep; const char* b2 = last ? nB : cB + (size_t)(t + 2) * kstep;
            const char* a3 = a2 + kstep; const char* b3 = b2 + kstep;
            if (last && has_next) S.a_ready(nxt);
            PG8_LDB(B0, 0, 0); PG8_SCHED; PG8_LDA(At, 0, 0); PG8_STAGE(PG8_SA(1, 1), a1 + hstep, voffA);
            PG8_WAIT_L(8); PG8_BAR; PG8_WAIT_L(0); PG8_MMA(0, 0, At, B0); PG8_BAR; PG8_SCHED;
            PG8_LDB(B1, 0, 1); PG8_STAGE(PG8_SB(0, 0), b2, voffB);
            PG8_BAR; PG8_WAIT_L(0); PG8_MMA(0, 1, At, B1); PG8_BAR;
            PG8_LDA(At, 0, 1); PG8_STAGE(PG8_SA(0, 0), a2, voffA);
            PG8_BAR; PG8_WAIT_L(0); PG8_MMA(1, 0, At, B0); PG8_BAR; PG8_SCHED;
            PG8_STAGE(PG8_SB(0, 1), b2 + hstep, voffB);
            PG8_WAIT_V(6); PG8_BAR; PG8_MMA(1, 1, At, B1); PG8_BAR;
            PG8_LDB(B0, 1, 0); PG8_SCHED; PG8_LDA(At, 1, 0); PG8_STAGE(PG8_SA(0, 1), a2 + hstep, voffA);
            PG8_WAIT_L(8); PG8_BAR; PG8_WAIT_L(0); PG8_MMA(0, 0, At, B0); PG8_BAR; PG8_SCHED;
            PG8_LDB(B1, 1, 1); PG8_STAGE(PG8_SB(1, 0), b3, voffB);
            PG8_BAR; PG8_WAIT_L(0); PG8_MMA(0, 1, At, B1); PG8_BAR;
            PG8_LDA(At, 1, 1); PG8_STAGE(PG8_SA(1, 0), a3, voffA);
            PG8_BAR; PG8_WAIT_L(0); PG8_MMA(1, 0, At, B0); PG8_BAR; PG8_SCHED;
            PG8_STAGE(PG8_SB(1, 1), b3 + hstep, voffB);
            PG8_WAIT_V(6); PG8_BAR; PG8_MMA(1, 1, At, B1); PG8_BAR;
        }
        PG8_STAMP();
        if constexpr (!Epi::AFTER_DRAIN) { E(acc, cur, wr, wc, fr, fq); S.done(cur); }
        PG8_STAMP();
        if (!has_next) break;
#pragma unroll
        for (int a = 0; a < 2; ++a)
#pragma unroll
            for (int b = 0; b < 2; ++b)
#pragma unroll
                for (int m = 0; m < 4; ++m)
#pragma unroll
                    for (int n = 0; n < 2; ++n) acc[a][b][m][n] = (f32x4){0.f, 0.f, 0.f, 0.f};
        cur = nxt; cA = nA; cB = nB; ++ui;
    }
    PG8_WAIT_V(0);
    if (wr == 0) PG8_BAR;
    PG8_BAR;
    if constexpr (Epi::AFTER_DRAIN) { E.fused(acc, cur, wr, wc, fr, fq, lds, wid, lane); S.done(cur); }
    PG8_STAMP();
    if (STAMP && wid == 0) { stamps[lane] = lane < nts ? (((unsigned long long)(unsigned)ts_hi << 32) | (unsigned)ts_lo) : 0ull;
        if (lane == 62) stamps[62] = rt_entry; if (lane == 63) stamps[63] = (unsigned long long)wall_clock64(); }
#undef PG8_STAMP
#undef PG8_SA
#undef PG8_SB
#undef PG8_STAGE
#undef PG8_LDA
#undef PG8_LDB
#undef PG8_MMA
#undef PG8_WAIT_V
#undef PG8_WAIT_L
#undef PG8_BAR
#undef PG8_SCHED
}
}
using pg8::bf16_t; using pg8::bf16x8; using pg8::f32x4; using pg8::u32x4; using pg8::cvt_pk_bf16; using pg8::Unit;
#define LAS __attribute__((address_space(3)))
typedef unsigned u32x2 __attribute__((ext_vector_type(2)));
typedef float f32x2 __attribute__((ext_vector_type(2)));

constexpr int DM = 1024, NB = 8, SEQ = 2048, DEPTH = 4, DSEQ = 16;
constexpr int TPR = NB * SEQ, T = TPR + NB * DSEQ, TP = 16640;
constexpr int NIN = 4624, NINP = 4864, XW = 1536, DFF = 4096, MIXW = 2048;
constexpr float ALPHA = 1.6817928305074290f;
constexpr float LN_EPS = 1e-5f, RMS_EPS = 1e-5f;
constexpr size_t SZ_ACT = (size_t)TP * 1024 * 2;
constexpr size_t WS_XB = 0;
constexpr size_t WS_YD = WS_XB;
constexpr size_t WS_UG = WS_XB + SZ_ACT, WS_VG = WS_UG + SZ_ACT, WS_Z = WS_VG + SZ_ACT, WS_XBC = WS_Z + SZ_ACT;
constexpr size_t WS_H = WS_UG;
constexpr size_t WS_MIX = WS_XBC + (size_t)TP * XW * 2;
constexpr size_t WS_DT = WS_MIX + (size_t)TP * MIXW * 2;
constexpr size_t WS_ACUM = WS_DT + (size_t)TP * 16 * 4;
constexpr size_t WS_VST = WS_ACUM + (size_t)TP * 16 * 4;
constexpr size_t WS_CN = WS_VST + (size_t)TP * 16 * 8;
constexpr int NST = 2048 + 128;
constexpr size_t WS_ST = WS_CN + (size_t)TP * 256 * 2;
constexpr size_t WS_DEC = WS_ST + (size_t)NST * 8192 * 2;
constexpr size_t WS_WOUT = WS_DEC + 16384;
constexpr size_t WS_WF1 = WS_WOUT + (size_t)1024 * 2048 * 2;
constexpr size_t WS_WIN = WS_WF1;
constexpr size_t WS_WF2 = WS_WF1 + (size_t)NINP * 1024 * 2;
constexpr size_t WS_GW = WS_WF2 + (size_t)4096 * 1024 * 2;
constexpr size_t WS_BAR = WS_GW + (size_t)DEPTH * 8 * 128 * 128 * 2;
constexpr size_t WS_END = WS_BAR + 16384;
static_assert(WS_XBC + (size_t)TP * XW * 2 - WS_UG >= (size_t)TP * DFF * 2, "H alias");
static_assert(WS_END <= (size_t)330883840, "workspace");
constexpr size_t O_YP = 0, O_YS = 16777216, O_SSMP = 16908288, O_CONVP = 21102592, O_SSMS = 21250048, O_CONVS = 25444352, O_VS = 25591808;
constexpr int LDS_BYTES = 135168;

struct Params {
  const float* in[22]; float* out; unsigned char* ws; int ph_lo, ph_hi;
};
struct InProxy { const Params& p; int z; __device__ __forceinline__ const float* operator[](int k) const { return p.in[k + z]; } };
struct Lp { InProxy in; unsigned char* ws; float* out; int tid, bid, G; };

__device__ __forceinline__ float bf2f(unsigned short b) { return __uint_as_float(((unsigned)b) << 16); }
__device__ __forceinline__ float lo2f(unsigned w) { return __uint_as_float(w << 16); }
__device__ __forceinline__ float hi2f(unsigned w) { return __uint_as_float(w & 0xffff0000u); }
__device__ __forceinline__ unsigned short f2bf(float f) { return (unsigned short)(cvt_pk_bf16(f, 0.f) & 0xffffu); }
__device__ __forceinline__ float gelu_t(float x) { const float u = 0.7978845608f * (x + 0.044715f * x * x * x); return x * __builtin_amdgcn_rcpf(1.0f + __builtin_amdgcn_exp2f(-2.885390082f * u)); }
__device__ __forceinline__ float silu_f(float x) { return x * __builtin_amdgcn_rcpf(1.0f + __builtin_amdgcn_exp2f(-1.442695041f * x)); }
__device__ __forceinline__ float exp_f(float x) { return __builtin_amdgcn_exp2f(1.442695041f * x); }
__device__ __forceinline__ float softplus_f(float x) { return x > 20.f ? x : log1pf(__expf(x)); }
__device__ __forceinline__ void unpack8(const u32x4 w, float (&f)[8]) { f[0] = lo2f(w.x); f[1] = hi2f(w.x); f[2] = lo2f(w.y); f[3] = hi2f(w.y); f[4] = lo2f(w.z); f[5] = hi2f(w.z); f[6] = lo2f(w.w); f[7] = hi2f(w.w); }

struct EpiIn {
  static constexpr bool PERM = true, AFTER_DRAIN = false;
  bf16_t *UG, *VG, *Z, *XBC; float* DT; f32x2* VST;
  __device__ __forceinline__ void operator()(const f32x4 (&acc)[2][2][4][2], const Unit& u, int wr, int wc, int fr, int fq) const {
    const int row0 = u.pm * 256 + wr * 64 + fr; const int pn = u.pn;
    if (pn < 18) {
      bf16_t* base; int ld, colt;
      if (pn < 4) { base = UG; ld = 1024; colt = pn * 256; } else if (pn < 8) { base = VG; ld = 1024; colt = (pn - 4) * 256; }
      else if (pn < 12) { base = Z; ld = 1024; colt = (pn - 8) * 256; } else { base = XBC; ld = XW; colt = (pn - 12) * 256; }
      const int col0 = colt + wc * 32 + 8 * fq; const bool act = pn < 8;
#pragma unroll
      for (int ai = 0; ai < 2; ++ai)
#pragma unroll
        for (int m = 0; m < 4; ++m) { bf16_t* rowp = base + (size_t)(row0 + ai * 128 + m * 16) * ld + col0; float rs = 0.f, rq = 0.f;
#pragma unroll
          for (int bj = 0; bj < 2; ++bj) { f32x4 v0 = acc[ai][bj][m][0], v1 = acc[ai][bj][m][1];
            if (act) {
#pragma unroll
              for (int j = 0; j < 4; ++j) { v0[j] = gelu_t(v0[j]); v1[j] = gelu_t(v1[j]); } }
            if (act) {
#pragma unroll
              for (int j = 0; j < 4; ++j) { rs += v0[j] + v1[j]; rq += v0[j] * v0[j] + v1[j] * v1[j]; } }
            u32x4 w; w.x = cvt_pk_bf16(v0[0], v0[1]); w.y = cvt_pk_bf16(v0[2], v0[3]); w.z = cvt_pk_bf16(v1[0], v1[1]); w.w = cvt_pk_bf16(v1[2], v1[3]);
            *(u32x4*)(rowp + bj * 128) = w; }
          if (pn >= 4 && pn < 8) { rs += __shfl_xor(rs, 16); rs += __shfl_xor(rs, 32); rq += __shfl_xor(rq, 16); rq += __shfl_xor(rq, 32);
            if (fq == 0) VST[(size_t)(row0 + ai * 128 + m * 16) * 16 + (pn - 4) * 4 + wc] = (f32x2){rs, rq}; } }
    } else if (wc == 0 && fq < 2) {
#pragma unroll
      for (int ai = 0; ai < 2; ++ai)
#pragma unroll
        for (int m = 0; m < 4; ++m) { float* p = DT + (size_t)(row0 + ai * 128 + m * 16) * 16 + 8 * fq; *(f32x4*)p = acc[ai][0][m][0]; *(f32x4*)(p + 4) = acc[ai][0][m][1]; }
    }
  }
};
struct EpiRes {
  static constexpr bool PERM = false, AFTER_DRAIN = false;
  const bf16_t* Xb; float* R;
  __device__ __forceinline__ void operator()(const f32x4 (&acc)[2][2][4][2], const Unit& u, int wr, int wc, int fr, int fq) const {
    const int row0 = u.pm * 256 + wr * 64 + fr, col0 = u.pn * 256 + wc * 32 + 4 * fq;
#pragma unroll
    for (int ai = 0; ai < 2; ++ai)
#pragma unroll
      for (int m = 0; m < 4; ++m) { const size_t off = (size_t)(row0 + ai * 128 + m * 16) * 1024 + col0;
#pragma unroll
        for (int bj = 0; bj < 2; ++bj)
#pragma unroll
          for (int n = 0; n < 2; ++n) { const u32x2 x = *(const u32x2*)(Xb + off + bj * 128 + n * 16); const f32x4 xf = {lo2f(x.x), hi2f(x.x), lo2f(x.y), hi2f(x.y)}; *(f32x4*)(R + off + bj * 128 + n * 16) = xf * ALPHA + acc[ai][bj][m][n]; } }
  }
};
struct EpiRelu2 {
  static constexpr bool PERM = true, AFTER_DRAIN = false;
  bf16_t* H;
  __device__ __forceinline__ void operator()(const f32x4 (&acc)[2][2][4][2], const Unit& u, int wr, int wc, int fr, int fq) const {
    const int row0 = u.pm * 256 + wr * 64 + fr, col0 = u.pn * 256 + wc * 32 + 8 * fq;
#pragma unroll
    for (int ai = 0; ai < 2; ++ai)
#pragma unroll
      for (int m = 0; m < 4; ++m) { bf16_t* rowp = H + (size_t)(row0 + ai * 128 + m * 16) * DFF + col0;
#pragma unroll
        for (int bj = 0; bj < 2; ++bj) { f32x4 v0 = acc[ai][bj][m][0], v1 = acc[ai][bj][m][1];
#pragma unroll
          for (int j = 0; j < 4; ++j) { const float a = fmaxf(v0[j], 0.f), b = fmaxf(v1[j], 0.f); v0[j] = a * a; v1[j] = b * b; }
          u32x4 w; w.x = cvt_pk_bf16(v0[0], v0[1]); w.y = cvt_pk_bf16(v0[2], v0[3]); w.z = cvt_pk_bf16(v1[0], v1[1]); w.w = cvt_pk_bf16(v1[2], v1[3]);
          *(u32x4*)(rowp + bj * 128) = w; } }
  }
};

struct CvtJob { const float* W; bf16_t* Wt; int K, N, ntn, ntiles; };
__device__ __forceinline__ void cvt_run(LAS unsigned char* lds, const CvtJob& j0, const CvtJob& j1, const CvtJob& j2, int j, int nw) {
  LAS float* tl = (LAS float*)lds; int tid_ = threadIdx.x; asm volatile("" : "+v"(tid_)); const int tid = tid_;
  const int e0 = j0.ntiles, e1 = e0 + j1.ntiles, e2 = e1 + j2.ntiles;
  for (int t0 = j * 4; t0 < e2; t0 += nw * 4) {
    f32x4 v[4][2];
#pragma unroll
    for (int u = 0; u < 4; ++u) { const int t = t0 + u < e2 ? t0 + u : e2 - 1;
      const CvtJob& J = t < e0 ? j0 : (t < e1 ? j1 : j2); const int tt = t < e0 ? t : (t < e1 ? t - e0 : t - e1); const int kt = tt / J.ntn, nt = tt - kt * J.ntn, k0 = kt * 64, n0 = nt * 64; int nn = (tid & 15) * 4;
      const bool inr = n0 + nn < J.N; if (!inr) nn = 0;
      const float* src = J.W + (size_t)(k0 + (tid >> 4)) * J.N + (inr ? n0 + nn : 0);
      v[u][0] = *(const f32x4*)src; v[u][1] = *(const f32x4*)(src + (size_t)32 * J.N);
      if (!inr) { v[u][0] = (f32x4){0.f, 0.f, 0.f, 0.f}; v[u][1] = v[u][0]; } }
#pragma unroll
    for (int u = 0; u < 4; ++u)
#pragma unroll
      for (int it = 0; it < 2; ++it) { LAS float* d = tl + u * 4160 + ((tid >> 4) + it * 32) * 65 + (tid & 15) * 4; d[0] = v[u][it][0]; d[1] = v[u][it][1]; d[2] = v[u][it][2]; d[3] = v[u][it][3]; }
    __syncthreads();
#pragma unroll
    for (int u = 0; u < 4; ++u) { const int t = t0 + u;
      if (t < e2) { const CvtJob& J = t < e0 ? j0 : (t < e1 ? j1 : j2); const int tt = t < e0 ? t : (t < e1 ? t - e0 : t - e1); const int kt = tt / J.ntn, nt = tt - kt * J.ntn, k0 = kt * 64, n0 = nt * 64;
        const int nn = tid >> 3, kk = (tid & 7) * 8; float f[8];
#pragma unroll
        for (int i = 0; i < 8; ++i) f[i] = tl[u * 4160 + (kk + i) * 65 + nn];
        u32x4 w; w.x = cvt_pk_bf16(f[0], f[1]); w.y = cvt_pk_bf16(f[2], f[3]); w.z = cvt_pk_bf16(f[4], f[5]); w.w = cvt_pk_bf16(f[6], f[7]);
        *(u32x4*)(J.Wt + (size_t)(n0 + nn) * J.K + k0 + kk) = w; } }
    __syncthreads();
  }
}
template <int R4> __device__ __forceinline__ bf16x8 tr_frag(unsigned addr) {
  u32x2 lo, hi; asm volatile("ds_read_b64_tr_b16 %0, %2\n\tds_read_b64_tr_b16 %1, %2 offset:%3\n\ts_waitcnt lgkmcnt(0)" : "=&v"(lo), "=&v"(hi) : "v"(addr), "n"(R4) : "memory");
  u32x4 r; r.x = lo.x; r.y = lo.y; r.z = hi.x; r.w = hi.y; return __builtin_bit_cast(bf16x8, r);
}

template <int R4> __device__ __forceinline__ void tr_frag4(unsigned a0, unsigned a1, unsigned a2, unsigned a3, bf16x8 (&out)[4]) {
  u32x2 l0, h0, l1, h1, l2, h2, l3, h3;
  asm volatile("ds_read_b64_tr_b16 %0, %8\n\tds_read_b64_tr_b16 %1, %8 offset:%12\n\tds_read_b64_tr_b16 %2, %9\n\tds_read_b64_tr_b16 %3, %9 offset:%12\n\t"
               "ds_read_b64_tr_b16 %4, %10\n\tds_read_b64_tr_b16 %5, %10 offset:%12\n\tds_read_b64_tr_b16 %6, %11\n\tds_read_b64_tr_b16 %7, %11 offset:%12\n\ts_waitcnt lgkmcnt(0)"
               : "=&v"(l0), "=&v"(h0), "=&v"(l1), "=&v"(h1), "=&v"(l2), "=&v"(h2), "=&v"(l3), "=&v"(h3) : "v"(a0), "v"(a1), "v"(a2), "v"(a3), "n"(R4) : "memory");
  u32x4 r; r.x = l0.x; r.y = l0.y; r.z = h0.x; r.w = h0.y; out[0] = __builtin_bit_cast(bf16x8, r); r.x = l1.x; r.y = l1.y; r.z = h1.x; r.w = h1.y; out[1] = __builtin_bit_cast(bf16x8, r);
  r.x = l2.x; r.y = l2.y; r.z = h2.x; r.w = h2.y; out[2] = __builtin_bit_cast(bf16x8, r); r.x = l3.x; r.y = l3.y; r.z = h3.x; r.w = h3.y; out[3] = __builtin_bit_cast(bf16x8, r);
}

constexpr int PT = 136;
__device__ __forceinline__ void gmlp_item(LAS unsigned char* lds, const Lp& p, int l, int rowbase, int nrows, int h, float* vout  ) {
  int tid_ = threadIdx.x; asm volatile("" : "+v"(tid_)); const int tid = tid_, wid = __builtin_amdgcn_readfirstlane(tid >> 6), lane = tid & 63, fr = lane & 15, fq = lane >> 4;
  const bf16_t* VG = (const bf16_t*)(p.ws + WS_VG); const bf16_t* UG = (const bf16_t*)(p.ws + WS_UG); bf16_t* MIX = (bf16_t*)(p.ws + WS_MIX);
  const bf16_t* GW = (const bf16_t*)(p.ws + WS_GW) + (size_t)(l * 8 + h) * 128 * 128;
  LAS bf16_t* vimg = (LAS bf16_t*)lds; LAS f32x2* st = (LAS f32x2*)(lds + 128 * PT * 2);
  if (tid < 128) { float mean = 0.f, rstd = 0.f;
    if (tid < nrows) { const f32x4* q = (const f32x4*)(p.ws + WS_VST + (size_t)(rowbase + tid) * 128); float s = 0.f, ss = 0.f;
#pragma unroll
      for (int i = 0; i < 8; ++i) { const f32x4 v = q[i]; s += v[0] + v[2]; ss += v[1] + v[3]; }
      mean = s * (1.0f / 1024.0f); rstd = rsqrtf(fmaxf(ss * (1.0f / 1024.0f) - mean * mean, 0.f) + LN_EPS); }
    st[tid] = (f32x2){mean, rstd}; }
  __syncthreads();
  { const int s = tid >> 2, cg0 = (tid & 3) * 32; const f32x2 ms = st[s]; const float* G = p.in[5] + l * 1024 + h * 128 + cg0; const float* Bb = p.in[6] + l * 1024 + h * 128 + cg0;
#pragma unroll
    for (int i = 0; i < 4; ++i) { float f[8];
      if (s < nrows) { unpack8(*(const u32x4*)(VG + (size_t)(rowbase + s) * 1024 + h * 128 + cg0 + 8 * i), f);
#pragma unroll
        for (int e = 0; e < 8; ++e) f[e] = (f[e] - ms.x) * ms.y * G[8 * i + e] + Bb[8 * i + e];
        if (vout) { float* o = vout + (size_t)s * 1024 + h * 128 + cg0 + 8 * i; *(f32x4*)o = (f32x4){f[0], f[1], f[2], f[3]}; *(f32x4*)(o + 4) = (f32x4){f[4], f[5], f[6], f[7]}; }
      } else {
#pragma unroll
        for (int e = 0; e < 8; ++e) f[e] = 0.f; }
      u32x4 w; w.x = cvt_pk_bf16(f[0], f[1]); w.y = cvt_pk_bf16(f[2], f[3]); w.z = cvt_pk_bf16(f[4], f[5]); w.w = cvt_pk_bf16(f[6], f[7]);
      *(LAS u32x4*)(vimg + s * PT + cg0 + 8 * i) = w; } }
  __syncthreads();
  if (wid * 16 < nrows) {
    f32x4 acc[8];
#pragma unroll
    for (int n = 0; n < 8; ++n) acc[n] = (f32x4){0.f, 0.f, 0.f, 0.f};
    const int nks = (wid * 16 + 15) / 32 + 1; const unsigned lbase = (unsigned)(size_t)lds;
    for (int ks = 0; ks < nks; ++ks) { const bf16x8 a = *(const bf16x8*)(GW + (size_t)(wid * 16 + fr) * 128 + ks * 32 + fq * 8);
#pragma unroll
      for (int n4 = 0; n4 < 2; ++n4) { bf16x8 bb[4]; const unsigned a0 = lbase + (unsigned)(((ks * 32 + fq * 8 + (fr >> 2)) * PT + n4 * 64 + 4 * (fr & 3)) * 2); tr_frag4<4 * PT * 2>(a0, a0 + 32, a0 + 64, a0 + 96, bb);
#pragma unroll
        for (int n = 0; n < 4; ++n) acc[n4 * 4 + n] = __builtin_amdgcn_mfma_f32_16x16x32_bf16(bb[n], a, acc[n4 * 4 + n], 0, 0, 0); } }
    const int t = wid * 16 + fr;
    if (t < nrows) { const float bs = p.in[8][(l * 8 + h) * 128 + t]; const size_t row = (size_t)(rowbase + t);
#pragma unroll
      for (int n = 0; n < 8; ++n) { const int col = h * 128 + n * 16 + fq * 4; const u32x2 ug = *(const u32x2*)(UG + row * 1024 + col);
        u32x2 w; w.x = cvt_pk_bf16(lo2f(ug.x) * (acc[n][0] + bs), hi2f(ug.x) * (acc[n][1] + bs)); w.y = cvt_pk_bf16(lo2f(ug.y) * (acc[n][2] + bs), hi2f(ug.y) * (acc[n][3] + bs));
        *(u32x2*)(MIX + row * MIXW + col) = w; } } }
  __syncthreads();
}
constexpr int XP = 72;
constexpr int L_BM = 0, L_CM = 128 * PT * 2, L_XH = 2 * 128 * PT * 2, L_XS = L_XH + 128 * XP * 2, L_AC = L_XS + 128 * XP * 2, L_DT = L_AC + 4096;
static_assert(L_DT + 4096 <= LDS_BYTES, "LDS");
__device__ __forceinline__ size_t st_item(int b, int c, int h, bool sample) { return sample ? (size_t)(2048 + b * 16 + h) : (size_t)((b * 16 + c) * 16 + h); }
__device__ __forceinline__ void ssd_ma_item(LAS unsigned char* lds, const Lp& p, int l, int b, int c, int g, bool sample) {
  int tid_ = threadIdx.x; asm volatile("" : "+v"(tid_)); const int tid = tid_, wid = __builtin_amdgcn_readfirstlane(tid >> 6), lane = tid & 63, fr = lane & 15, fq = lane >> 4;
  const int seq0 = sample ? TPR + b * DSEQ : b * SEQ, pos0 = c * 128, crow = seq0 + pos0, nrows = sample ? DSEQ : 128;
  const bf16_t* XBC = (const bf16_t*)(p.ws + WS_XBC); const float* DT = (const float*)(p.ws + WS_DT);
  LAS bf16_t* Bm = (LAS bf16_t*)(lds + L_BM); LAS bf16_t* Cm = (LAS bf16_t*)(lds + L_CM); LAS bf16_t* xh = (LAS bf16_t*)(lds + L_XH); LAS bf16_t* xs = (LAS bf16_t*)(lds + L_XS);
  LAS float* acum = (LAS float*)(lds + L_AC); LAS float* dtv = (LAS float*)(lds + L_DT); const unsigned lbase = (unsigned)(size_t)lds;
  const float* convw = p.in[9] + (size_t)l * 4 * XW; const float* convb = p.in[10] + (size_t)l * XW; const float* cstate = p.in[3] + (size_t)(l * 8 + b) * 3 * XW;
  { const int h = g * 8 + wid; const float av = -__expf(p.in[12][l * 16 + h]), dtb = p.in[11][l * 16 + h];
    float d0 = 0.f, d1 = 0.f; if (lane < nrows) d0 = softplus_f(DT[(size_t)(crow + lane) * 16 + h] + dtb); if (lane + 64 < nrows) d1 = softplus_f(DT[(size_t)(crow + lane + 64) * 16 + h] + dtb);
    float s0 = d0 * av, s1 = d1 * av;
#pragma unroll
    for (int o = 1; o < 64; o <<= 1) { const float t0 = __shfl_up(s0, o), t1 = __shfl_up(s1, o); if (lane >= o) { s0 += t0; s1 += t1; } }
    s1 += __shfl(s0, 63);
    acum[wid * 128 + lane] = s0; acum[wid * 128 + 64 + lane] = s1; dtv[wid * 128 + lane] = d0; dtv[wid * 128 + 64 + lane] = d1;
    float* AC = (float*)(p.ws + WS_ACUM); if (lane < nrows) AC[(size_t)(crow + lane) * 16 + h] = s0; if (lane + 64 < nrows) AC[(size_t)(crow + lane + 64) * 16 + h] = s1;
    if (lane == 63) ((float*)(p.ws + WS_DEC))[st_item(b, c, h, sample)] = exp_f(s1); }
  { const int cgi = tid & 31, rr = tid >> 5; const int nn = (cgi & 15) * 8, ch = (cgi < 16 ? 1024 : 1280) + g * 128 + nn; const int j0 = rr * 8;
    float w0[8], w1[8], w2[8], w3[8], bb[8], p0[8], p1[8], p2[8];
#pragma unroll
    for (int e = 0; e < 8; ++e) { w0[e] = convw[ch + e]; w1[e] = convw[XW + ch + e]; w2[e] = convw[2 * XW + ch + e]; w3[e] = convw[3 * XW + ch + e]; bb[e] = convb[ch + e]; }
#pragma unroll
    for (int i = 0; i < 3; ++i) { const int pos = pos0 + j0 - 3 + i; float f[8];
      if (pos >= 0) unpack8(*(const u32x4*)(XBC + (size_t)(seq0 + pos) * XW + ch), f);
      else {
#pragma unroll
        for (int e = 0; e < 8; ++e) f[e] = sample ? cstate[(3 + pos) * XW + ch + e] : 0.f; }
#pragma unroll
      for (int e = 0; e < 8; ++e) { if (i == 0) p0[e] = f[e]; else if (i == 1) p1[e] = f[e]; else p2[e] = f[e]; } }
    bf16_t* CN = (bf16_t*)(p.ws + WS_CN);
#pragma unroll
    for (int jj = 0; jj < 8; ++jj) { const int j = j0 + jj; float cur[8], o[8]; unpack8(*(const u32x4*)(XBC + (size_t)(crow + j) * XW + ch), cur);
#pragma unroll
      for (int e = 0; e < 8; ++e) { const float v = bb[e] + w0[e] * p0[e] + w1[e] * p1[e] + w2[e] * p2[e] + w3[e] * cur[e]; o[e] = (j < nrows) ? silu_f(v) : 0.f; p0[e] = p1[e]; p1[e] = p2[e]; p2[e] = cur[e]; }
      u32x4 w; w.x = cvt_pk_bf16(o[0], o[1]); w.y = cvt_pk_bf16(o[2], o[3]); w.z = cvt_pk_bf16(o[4], o[5]); w.w = cvt_pk_bf16(o[6], o[7]);
      if (cgi < 16) *(LAS u32x4*)(Bm + j * PT + nn) = w; else { *(LAS u32x4*)(Cm + j * PT + nn) = w; if (j < nrows) *(u32x4*)(CN + (size_t)(crow + j) * 256 + g * 128 + nn) = w; } } }
  __syncthreads();
  f32x4 cb[8];
#pragma unroll
  for (int jt = 0; jt < 8; ++jt) cb[jt] = (f32x4){0.f, 0.f, 0.f, 0.f};
#pragma unroll
  for (int ks = 0; ks < 4; ++ks) { const bf16x8 bq = *(const LAS bf16x8*)(Cm + (wid * 16 + fr) * PT + ks * 32 + fq * 8);
#pragma unroll
    for (int jt = 0; jt < 8; ++jt) if (jt <= wid) { const bf16x8 a = *(const LAS bf16x8*)(Bm + (jt * 16 + fr) * PT + ks * 32 + fq * 8); cb[jt] = __builtin_amdgcn_mfma_f32_16x16x32_bf16(a, bq, cb[jt], 0, 0, 0); } }
  __syncthreads();
  LAS bf16_t* Pm = Cm;
  bf16_t* YD = (bf16_t*)p.out; bf16_t* ST = (bf16_t*)(p.ws + WS_ST);
  for (int h8 = 0; h8 < 8; ++h8) { const int h = g * 8 + h8; const float Dh = p.in[13][l * 16 + h]; const float alast = acum[h8 * 128 + 127];
    { const int cgi = tid & 7, rr = tid >> 3; const int nn = cgi * 8, ch = h * 64 + nn, j0 = rr * 2; float w0[8], w1[8], w2[8], w3[8], bb[8], r[5][8];
#pragma unroll
      for (int e = 0; e < 8; ++e) { w0[e] = convw[ch + e]; w1[e] = convw[XW + ch + e]; w2[e] = convw[2 * XW + ch + e]; w3[e] = convw[3 * XW + ch + e]; bb[e] = convb[ch + e]; }
#pragma unroll
      for (int i = 0; i < 5; ++i) { const int pos = pos0 + j0 - 3 + i;
        if (pos >= 0) unpack8(*(const u32x4*)(XBC + (size_t)(seq0 + pos) * XW + ch), r[i]);
        else {
#pragma unroll
          for (int e = 0; e < 8; ++e) r[i][e] = sample ? cstate[(3 + pos) * XW + ch + e] : 0.f; } }
#pragma unroll
      for (int jj = 0; jj < 2; ++jj) { const int j = j0 + jj; float o[8], os[8]; const float wj = exp_f(alast - acum[h8 * 128 + j]) * dtv[h8 * 128 + j];
#pragma unroll
        for (int e = 0; e < 8; ++e) { const float v = bb[e] + w0[e] * r[jj][e] + w1[e] * r[jj + 1][e] + w2[e] * r[jj + 2][e] + w3[e] * r[jj + 3][e]; o[e] = (j < nrows) ? silu_f(v) : 0.f; os[e] = o[e] * wj; }
        u32x4 w; w.x = cvt_pk_bf16(o[0], o[1]); w.y = cvt_pk_bf16(o[2], o[3]); w.z = cvt_pk_bf16(o[4], o[5]); w.w = cvt_pk_bf16(o[6], o[7]); *(LAS u32x4*)(xh + j * XP + nn) = w;
        w.x = cvt_pk_bf16(os[0], os[1]); w.y = cvt_pk_bf16(os[2], os[3]); w.z = cvt_pk_bf16(os[4], os[5]); w.w = cvt_pk_bf16(os[6], os[7]); *(LAS u32x4*)(xs + j * XP + nn) = w; } }
    { const int i = wid * 16 + fr; const float ai = acum[h8 * 128 + i];
#pragma unroll
      for (int jt = 0; jt < 8; ++jt) { float v[4];
#pragma unroll
        for (int r = 0; r < 4; ++r) { const int j = jt * 16 + fq * 4 + r; float x = 0.f; if (jt <= wid && j <= i) x = cb[jt][r] * exp_f(ai - acum[h8 * 128 + j]) * dtv[h8 * 128 + j]; if (j == i) x += Dh; v[r] = x; }
        u32x2 w; w.x = cvt_pk_bf16(v[0], v[1]); w.y = cvt_pk_bf16(v[2], v[3]); *(LAS u32x2*)(Pm + i * PT + jt * 16 + fq * 4) = w; } }
    __syncthreads();
    { f32x4 y[4], hs[4];
#pragma unroll
      for (int pt = 0; pt < 4; ++pt) { y[pt] = (f32x4){0.f, 0.f, 0.f, 0.f}; hs[pt] = y[pt]; }
      const int nks = (wid * 16 + 15) / 32 + 1;
      for (int ks = 0; ks < nks; ++ks) { const bf16x8 bq = *(const LAS bf16x8*)(Pm + (wid * 16 + fr) * PT + ks * 32 + fq * 8);
        bf16x8 xa[4]; const unsigned a0 = lbase + L_XH + (unsigned)(((ks * 32 + fq * 8 + (fr >> 2)) * XP + 4 * (fr & 3)) * 2); tr_frag4<4 * XP * 2>(a0, a0 + 32, a0 + 64, a0 + 96, xa);
#pragma unroll
        for (int pt = 0; pt < 4; ++pt) y[pt] = __builtin_amdgcn_mfma_f32_16x16x32_bf16(xa[pt], bq, y[pt], 0, 0, 0); }
#pragma unroll
      for (int ks = 0; ks < 4; ++ks) { const bf16x8 a = tr_frag<4 * PT * 2>(lbase + L_BM + (unsigned)(((ks * 32 + fq * 8 + (fr >> 2)) * PT + wid * 16 + 4 * (fr & 3)) * 2));
        bf16x8 xb[4]; const unsigned a0 = lbase + L_XS + (unsigned)(((ks * 32 + fq * 8 + (fr >> 2)) * XP + 4 * (fr & 3)) * 2); tr_frag4<4 * XP * 2>(a0, a0 + 32, a0 + 64, a0 + 96, xb);
#pragma unroll
        for (int pt = 0; pt < 4; ++pt) hs[pt] = __builtin_amdgcn_mfma_f32_16x16x32_bf16(a, xb[pt], hs[pt], 0, 0, 0); }
      const int i = wid * 16 + fr; bf16_t* sti = ST + st_item(b, c, h, sample) * 8192;
#pragma unroll
      for (int pt = 0; pt < 4; ++pt) { u32x2 w;
        if (i < nrows) { w.x = cvt_pk_bf16(y[pt][0], y[pt][1]); w.y = cvt_pk_bf16(y[pt][2], y[pt][3]); *(u32x2*)(YD + (size_t)(crow + i) * 1024 + h * 64 + pt * 16 + fq * 4) = w; }
        w.x = cvt_pk_bf16(hs[pt][0], hs[pt][1]); w.y = cvt_pk_bf16(hs[pt][2], hs[pt][3]); *(u32x2*)(sti + (pt * 16 + fr) * 128 + wid * 16 + fq * 4) = w; } }
    __syncthreads();
  }
}
__device__ __forceinline__ void ssd_scan_phase(const Lp& p, int l) {
  bf16_t* ST = (bf16_t*)(p.ws + WS_ST); const float* DEC = (const float*)(p.ws + WS_DEC);
  for (int gid = p.bid * 512 + p.tid; gid < 8 * 16 * 64 * 16; gid += p.G * 512) { const int e8 = gid & 15, pp = (gid >> 4) & 63, h = (gid >> 10) & 15, b = gid >> 14; const size_t eoff = (size_t)pp * 128 + e8 * 8;
    u32x4 sv[16]; float dc[16];
#pragma unroll
    for (int c = 0; c < 16; ++c) { sv[c] = *(const u32x4*)(ST + st_item(b, c, h, false) * 8192 + eoff); dc[c] = DEC[st_item(b, c, h, false)]; }
    float hr[8];
#pragma unroll
    for (int e = 0; e < 8; ++e) hr[e] = 0.f;
#pragma unroll
    for (int c = 0; c < 16; ++c) { u32x4 w; w.x = cvt_pk_bf16(hr[0], hr[1]); w.y = cvt_pk_bf16(hr[2], hr[3]); w.z = cvt_pk_bf16(hr[4], hr[5]); w.w = cvt_pk_bf16(hr[6], hr[7]);
      *(u32x4*)(ST + st_item(b, c, h, false) * 8192 + eoff) = w; float f[8]; unpack8(sv[c], f);
#pragma unroll
      for (int e = 0; e < 8; ++e) hr[e] = dc[c] * hr[e] + f[e]; }
    { float* o = p.out + O_SSMP + (size_t)((l * 8 + b) * 16 + h) * 8192 + eoff; *(f32x4*)o = (f32x4){hr[0], hr[1], hr[2], hr[3]}; *(f32x4*)(o + 4) = (f32x4){hr[4], hr[5], hr[6], hr[7]}; }
    { const float* h0 = p.in[2] + (size_t)((l * 8 + b) * 16 + h) * 8192 + eoff; const f32x4 a = *(const f32x4*)h0, bq = *(const f32x4*)(h0 + 4); bf16_t* sp = ST + st_item(b, 0, h, true) * 8192 + eoff;
      float f[8]; unpack8(*(const u32x4*)sp, f); const float d = DEC[st_item(b, 0, h, true)];
      u32x4 w; w.x = cvt_pk_bf16(a[0], a[1]); w.y = cvt_pk_bf16(a[2], a[3]); w.z = cvt_pk_bf16(bq[0], bq[1]); w.w = cvt_pk_bf16(bq[2], bq[3]); *(u32x4*)sp = w;
      float* o = p.out + O_SSMS + (size_t)((l * 8 + b) * 16 + h) * 8192 + eoff;
      *(f32x4*)o = (f32x4){d * a[0] + f[0], d * a[1] + f[1], d * a[2] + f[2], d * a[3] + f[3]}; *(f32x4*)(o + 4) = (f32x4){d * bq[0] + f[4], d * bq[1] + f[5], d * bq[2] + f[6], d * bq[3] + f[7]}; }
  }
}
__device__ __forceinline__ void ssd_mc_item(LAS unsigned char* lds, const Lp& p, int l, int b, int c, int g, bool sample) {
  int tid_ = threadIdx.x; asm volatile("" : "+v"(tid_)); const int tid = tid_, wid = __builtin_amdgcn_readfirstlane(tid >> 6), lane = tid & 63, fr = lane & 15, fq = lane >> 4;
  const int crow = (sample ? TPR + b * DSEQ : b * SEQ) + c * 128, nrows = sample ? DSEQ : 128; const int i = wid * 16 + fr; const size_t row = (size_t)(crow + i); const bool ok = i < nrows, wok = wid * 16 < nrows;
  const bf16_t* CN = (const bf16_t*)(p.ws + WS_CN); const bf16_t* ST = (const bf16_t*)(p.ws + WS_ST); const bf16_t* YD = (const bf16_t*)p.out; const bf16_t* Z = (const bf16_t*)(p.ws + WS_Z);
  const float* AC = (const float*)(p.ws + WS_ACUM); bf16_t* MIX = (bf16_t*)(p.ws + WS_MIX); LAS bf16_t* hl = (LAS bf16_t*)lds;
  bf16x8 cf[4];
#pragma unroll
  for (int ks = 0; ks < 4; ++ks) cf[ks] = *(const bf16x8*)(CN + row * 256 + g * 128 + ks * 32 + fq * 8);
  float ss = 0.f; u32x2 keep[8][4];
#pragma unroll
  for (int r = 0; r < 2; ++r) {
    { u32x4 v[8];
#pragma unroll
      for (int q = 0; q < 8; ++q) { const int ch = tid + q * 512, hd = ch >> 10, wch = ch & 1023; v[q] = *(const u32x4*)(ST + st_item(b, c, g * 8 + r * 4 + hd, sample) * 8192 + wch * 8); }
#pragma unroll
      for (int q = 0; q < 8; ++q) { const int ch = tid + q * 512, hd = ch >> 10, wch = ch & 1023; *(LAS u32x4*)(hl + (hd * 64 + (wch >> 4)) * PT + (wch & 15) * 8) = v[q]; } }
    __syncthreads();
    if (wok) {
#pragma unroll
      for (int hd = 0; hd < 4; ++hd) { const int h = g * 8 + r * 4 + hd; f32x4 yy[4];
#pragma unroll
        for (int pt = 0; pt < 4; ++pt) yy[pt] = (f32x4){0.f, 0.f, 0.f, 0.f};
#pragma unroll
        for (int ks = 0; ks < 4; ++ks)
#pragma unroll
          for (int pt = 0; pt < 4; ++pt) { const bf16x8 a = *(const LAS bf16x8*)(hl + (hd * 64 + pt * 16 + fr) * PT + ks * 32 + fq * 8); yy[pt] = __builtin_amdgcn_mfma_f32_16x16x32_bf16(a, cf[ks], yy[pt], 0, 0, 0); }
        const float ei = ok ? exp_f(AC[row * 16 + h]) : 0.f;
#pragma unroll
        for (int pt = 0; pt < 4; ++pt) { const int col = h * 64 + pt * 16 + fq * 4; u32x2 yd = {0u, 0u}, zz = {0u, 0u}; if (ok) { yd = *(const u32x2*)(YD + row * 1024 + col); zz = *(const u32x2*)(Z + row * 1024 + col); }
          f32x4 v = yy[pt] * ei; v[0] = (v[0] + lo2f(yd.x)) * silu_f(lo2f(zz.x)); v[1] = (v[1] + hi2f(yd.x)) * silu_f(hi2f(zz.x)); v[2] = (v[2] + lo2f(yd.y)) * silu_f(lo2f(zz.y)); v[3] = (v[3] + hi2f(yd.y)) * silu_f(hi2f(zz.y));
          if (!ok) v = (f32x4){0.f, 0.f, 0.f, 0.f};
          ss += (v[0] * v[0] + v[1] * v[1]) + (v[2] * v[2] + v[3] * v[3]); keep[r * 4 + hd][pt].x = cvt_pk_bf16(v[0], v[1]); keep[r * 4 + hd][pt].y = cvt_pk_bf16(v[2], v[3]); } } }
    __syncthreads();
  }
  ss += __shfl_xor(ss, 16); ss += __shfl_xor(ss, 32);
  const float rstd = rsqrtf(ss * (1.0f / 512.0f) + RMS_EPS); const float* gm = p.in[14] + l * 1024 + g * 512;
  if (ok) {
#pragma unroll
    for (int h8 = 0; h8 < 8; ++h8)
#pragma unroll
      for (int pt = 0; pt < 4; ++pt) { const int cc = h8 * 64 + pt * 16 + fq * 4; const u32x2 w0 = keep[h8][pt]; const f32x4 gv = *(const f32x4*)(gm + cc);
        u32x2 w; w.x = cvt_pk_bf16(lo2f(w0.x) * rstd * gv[0], hi2f(w0.x) * rstd * gv[1]); w.y = cvt_pk_bf16(lo2f(w0.y) * rstd * gv[2], hi2f(w0.y) * rstd * gv[3]); *(u32x2*)(MIX + row * MIXW + 1024 + g * 512 + cc) = w; } }
}
template <int NT, int KIND> __device__ __forceinline__ void skinny_task(LAS unsigned char* lds, const Lp& p, const bf16_t* __restrict__ A, const bf16_t* __restrict__ Bt, int K, int rb, int cb) {
  int tid_ = threadIdx.x; asm volatile("" : "+v"(tid_)); const int tid = tid_, wid = __builtin_amdgcn_readfirstlane(tid >> 6), lane = tid & 63, fr = lane & 15, fq = lane >> 4;
  const int rt = wid & 1, ksp = wid >> 1, Kw = K >> 2, row = TPR + rb * 32 + rt * 16 + fr;
  const bf16_t* ap = A + (size_t)row * K + ksp * Kw + fq * 8; const bf16_t* bp = Bt + (size_t)(cb * 16 * NT + fr) * K + ksp * Kw + fq * 8;
  f32x4 acc[NT];
#pragma unroll
  for (int n = 0; n < NT; ++n) acc[n] = (f32x4){0.f, 0.f, 0.f, 0.f};
#pragma unroll 4
  for (int ks = 0; ks < (Kw >> 5); ++ks) { const bf16x8 a = *(const bf16x8*)(ap + ks * 32);
#pragma unroll
    for (int n = 0; n < NT; ++n) { const bf16x8 b = *(const bf16x8*)(bp + (size_t)n * 16 * K + ks * 32); acc[n] = __builtin_amdgcn_mfma_f32_16x16x32_bf16(b, a, acc[n], 0, 0, 0); } }
  LAS f32x4* red = (LAS f32x4*)lds;
  if (ksp > 0) {
#pragma unroll
    for (int n = 0; n < NT; ++n) red[(((ksp - 1) * 2 + rt) * NT + n) * 64 + lane] = acc[n]; }
  __syncthreads();
  if (ksp == 0) {
    float rs = 0.f, rq = 0.f; const int col0 = cb * 16 * NT + fq * 4;
#pragma unroll
    for (int n = 0; n < NT; ++n) { f32x4 v = acc[n];
#pragma unroll
      for (int s = 0; s < 3; ++s) v += red[((s * 2 + rt) * NT + n) * 64 + lane];
      const int col = col0 + n * 16;
      if (KIND == 1) { const u32x2 x = *(const u32x2*)((const bf16_t*)(p.ws + WS_XB) + (size_t)row * 1024 + col); const f32x4 xf = {lo2f(x.x), hi2f(x.x), lo2f(x.y), hi2f(x.y)}; *(f32x4*)(p.out + (size_t)row * 1024 + col) = xf * ALPHA + v; }
      else if (KIND == 2) { u32x2 w; const float a0 = fmaxf(v[0], 0.f), a1 = fmaxf(v[1], 0.f), a2 = fmaxf(v[2], 0.f), a3 = fmaxf(v[3], 0.f); w.x = cvt_pk_bf16(a0 * a0, a1 * a1); w.y = cvt_pk_bf16(a2 * a2, a3 * a3);
        *(u32x2*)((bf16_t*)(p.ws + WS_H) + (size_t)row * DFF + col) = w; }
      else {
        if (col < 2048) {
#pragma unroll
          for (int j = 0; j < 4; ++j) { v[j] = gelu_t(v[j]); rs += v[j]; rq += v[j] * v[j]; } }
        u32x2 w; w.x = cvt_pk_bf16(v[0], v[1]); w.y = cvt_pk_bf16(v[2], v[3]);
        if (col < 3072) *(u32x2*)((bf16_t*)(p.ws + (col < 1024 ? WS_UG : (col < 2048 ? WS_VG : WS_Z))) + (size_t)row * 1024 + (col & 1023)) = w;
        else if (col < 4608) *(u32x2*)((bf16_t*)(p.ws + WS_XBC) + (size_t)row * XW + (col - 3072)) = w;
        else if (col < 4624) *(f32x4*)((float*)(p.ws + WS_DT) + (size_t)row * 16 + (col - 4608)) = v; } }
    if (KIND == 0 && NT == 4) { const int cbk = cb - 16;
      rs += __shfl_xor(rs, 16); rs += __shfl_xor(rs, 32); rq += __shfl_xor(rq, 16); rq += __shfl_xor(rq, 32);
      if (cbk >= 0 && cbk < 16 && fq == 0) ((f32x2*)(p.ws + WS_VST))[(size_t)row * 16 + cbk] = (f32x2){rs, rq}; } }
  __syncthreads();
}
__device__ __forceinline__ void ln_phase(const Lp& p, const float* __restrict__ g, const float* __restrict__ b, const float* R, float* Xo, bf16_t* Xb) {
  const int tid = p.tid, wid = tid >> 6, lane = tid & 63;
  f32x4 gv[4], bv[4];
#pragma unroll
  for (int i = 0; i < 4; ++i) { gv[i] = *(const f32x4*)(g + i * 256 + lane * 4); bv[i] = *(const f32x4*)(b + i * 256 + lane * 4); }
  for (int row = p.bid * 8 + wid; row < T; row += p.G * 8) { f32x4 v[4]; float s = 0.f;
#pragma unroll
    for (int i = 0; i < 4; ++i) { v[i] = *(const f32x4*)(R + (size_t)row * 1024 + i * 256 + lane * 4); s += (v[i][0] + v[i][1]) + (v[i][2] + v[i][3]); }
#pragma unroll
    for (int o = 32; o >= 1; o >>= 1) s += __shfl_xor(s, o);
    const float mean = s * (1.0f / 1024.0f); float q = 0.f;
#pragma unroll
    for (int i = 0; i < 4; ++i) { const f32x4 d = v[i] - mean; q += (d[0] * d[0] + d[1] * d[1]) + (d[2] * d[2] + d[3] * d[3]); }
#pragma unroll
    for (int o = 32; o >= 1; o >>= 1) q += __shfl_xor(q, o);
    const float rstd = rsqrtf(q * (1.0f / 1024.0f) + LN_EPS);
#pragma unroll
    for (int i = 0; i < 4; ++i) { const f32x4 y = (v[i] - mean) * rstd * gv[i] + bv[i]; if (Xo) *(f32x4*)(Xo + (size_t)row * 1024 + i * 256 + lane * 4) = y;
      u32x2 w; w.x = cvt_pk_bf16(y[0], y[1]); w.y = cvt_pk_bf16(y[2], y[3]); *(u32x2*)(Xb + (size_t)row * 1024 + i * 256 + lane * 4) = w; } }
}
#define XB_TMO      128
#define XB_XCNT(j)  (256  + 64 * (j))
#define XB_XSUB(j)  (1280 + 64 * (j))
#define XB_XGEN(j)  (2304 + 64 * (j))
#define XB_TOP      3328
#define XB_TOPGEN   3392
#define XCD_BAR_WORDS 3456
#define XB_SPIN_CAP (1u << 18)

__device__ __forceinline__ unsigned xb_ld(unsigned* p)              { return __hip_atomic_load(p, __ATOMIC_RELAXED, __HIP_MEMORY_SCOPE_AGENT); }
__device__ __forceinline__ unsigned xb_add(unsigned* p, unsigned v) { return __hip_atomic_fetch_add(p, v, __ATOMIC_RELAXED, __HIP_MEMORY_SCOPE_AGENT); }
__device__ __forceinline__ unsigned xb_xcc_id() { return (unsigned)__builtin_amdgcn_s_getreg((3 << 11) | 20) & 0xFu; }
#define XB_SPIN(cond, bar) do { unsigned _sp = 0; while (cond) { __builtin_amdgcn_s_sleep(1); \
    if ((++_sp & 255u) == 0u) { if (xb_ld(&(bar)[XB_TMO])) break; if (_sp > XB_SPIN_CAP) { atomicAdd(&(bar)[XB_TMO], 1u); break; } } } } while (0)

struct XcdBarrier {
    unsigned* bar; unsigned x;
    volatile LAS unsigned* st;
};

__device__ __forceinline__ XcdBarrier xcd_barrier_post(unsigned* bar, volatile LAS unsigned* st) {
    XcdBarrier b; b.bar = bar; b.x = xb_xcc_id(); b.st = st;
    if (threadIdx.x == 0) (void)xb_add(&bar[XB_XCNT(b.x)], 1u);
    return b;
}
__device__ __forceinline__ void xcd_barrier_complete(unsigned* bar, unsigned x, unsigned& nloc, unsigned& nx) {
    const unsigned G = gridDim.x * gridDim.y * gridDim.z;
    unsigned sum, cnt, mine, sp = 0u;
    for (;;) {
        sum = 0u; cnt = 0u; mine = 0u;
#pragma unroll
        for (unsigned j = 0; j < 16; ++j) { const unsigned c = xb_ld(&bar[XB_XCNT(j)]); sum += c; cnt += (c > 0u) ? 1u : 0u; mine = (j == x) ? c : mine; }
        if (sum == G) break;
        __builtin_amdgcn_s_sleep(1);
        if ((++sp & 255u) == 0u) { if (xb_ld(&bar[XB_TMO])) break; if (sp > XB_SPIN_CAP) { atomicAdd(&bar[XB_TMO], 1u); break; } }
    }
    nloc = mine > 0u ? mine : 1u; nx = cnt > 0u ? cnt : 1u;
}

__device__ __forceinline__ void xcd_barrier(const XcdBarrier& b) {
    asm volatile("s_waitcnt vmcnt(0)" ::: "memory");
    __syncthreads();
    if (threadIdx.x == 0) {
        unsigned* bar = b.bar;
        __builtin_amdgcn_s_waitcnt(0);
        unsigned nloc = b.st[0], nx = b.st[1];
        if (nloc == 0u) { xcd_barrier_complete(bar, b.x, nloc, nx); b.st[0] = nloc; b.st[1] = nx; }
        const unsigned old = xb_add(&bar[XB_XSUB(b.x)], 1u);
        const unsigned gen = old / nloc;
        if (old + 1u == (gen + 1u) * nloc) {
            __builtin_amdgcn_fence(__ATOMIC_RELEASE, "agent");
            asm volatile("s_waitcnt vmcnt(0)" ::: "memory");
            const unsigned og = xb_add(&bar[XB_TOP], 1u);
            const unsigned tg = og / nx;
            if (og + 1u == (tg + 1u) * nx) xb_add(&bar[XB_TOPGEN], 1u);
            else XB_SPIN(xb_ld(&bar[XB_TOPGEN]) == tg, bar);
            __builtin_amdgcn_fence(__ATOMIC_ACQUIRE, "agent");
            xb_add(&bar[XB_XGEN(b.x)], 1u);
            asm volatile("s_waitcnt vmcnt(0)" ::: "memory");
        } else {
            XB_SPIN(xb_ld(&bar[XB_XGEN(b.x)]) == gen, bar);
            __builtin_amdgcn_fence(__ATOMIC_ACQUIRE, "agent");
            asm volatile("s_waitcnt vmcnt(0)" ::: "memory");
        }
    }
    __syncthreads();
}

constexpr int NK = 9, NPH = 1 + NK * DEPTH, XB_ST_OFF = LDS_BYTES - 16;
__device__ __forceinline__ void p0_phase(LAS unsigned char* lds, const Lp& p) {
  const int tid = p.tid, bid = p.bid, G = p.G; bf16_t* Xb = (bf16_t*)(p.ws + WS_XB); bf16_t* GW = (bf16_t*)(p.ws + WS_GW);
  for (size_t i = (size_t)bid * 512 + tid; i < (size_t)TP * 128; i += (size_t)G * 512) { const size_t e = i * 8; u32x4 w = {0u, 0u, 0u, 0u};
    if (e < (size_t)T * 1024) { const float* src = e < (size_t)TPR * 1024 ? p.in[0] + e : p.in[1] + (e - (size_t)TPR * 1024); const f32x4 a = *(const f32x4*)src, b = *(const f32x4*)(src + 4);
      w.x = cvt_pk_bf16(a[0], a[1]); w.y = cvt_pk_bf16(a[2], a[3]); w.z = cvt_pk_bf16(b[0], b[1]); w.w = cvt_pk_bf16(b[2], b[3]); }
    *(u32x4*)(Xb + e) = w; }
  for (int i = bid * 512 + tid; i < DEPTH * 8 * 128 * 128; i += G * 512) { const int s = i & 127, t = (i >> 7) & 127; GW[i] = s <= t ? f2bf(p.in[7][i]) : (bf16_t)0; }
  if (bid == 0) for (int i = tid; i < XCD_BAR_WORDS; i += 512) ((unsigned*)(p.ws + WS_BAR))[i] = 0u;
  const CvtJob j0{p.in[4], (bf16_t*)(p.ws + WS_WIN), 1024, NIN, NINP / 64, 16 * (NINP / 64)}, jn{nullptr, nullptr, 64, 64, 1, 0};
  cvt_run(lds, j0, jn, jn, bid, G);
}
__device__ __forceinline__ void ma_phase(LAS unsigned char* lds, const Lp& p, int l) {
  const int tid = p.tid, bid = p.bid, G = p.G; const bf16_t* XBC = (const bf16_t*)(p.ws + WS_XBC);
  for (int i = bid * 512 + tid; i < 2 * 8 * 3 * XW; i += G * 512) { const int smp = i / (8 * 3 * XW), r = i - smp * (8 * 3 * XW), b = r / (3 * XW), k = (r / XW) % 3, ch = r % XW;
    const size_t row = smp ? (size_t)(TPR + b * DSEQ + DSEQ - 3 + k) : (size_t)(b * SEQ + SEQ - 3 + k);
    p.out[(smp ? O_CONVS : O_CONVP) + (size_t)l * 8 * 3 * XW + r] = bf2f(XBC[row * XW + ch]); }
  for (int it = bid; it < 272; it += G) { const bool smp = it >= 256; const int i2 = it - 256;
    ssd_ma_item(lds, p, l, smp ? i2 >> 1 : it >> 5, smp ? 0 : (it >> 1) & 15, it & 1, smp); }
  const int skip = G > 32 ? 16 : 0;
  if (bid >= skip)
    for (int it = bid - skip; it < 1024 + 64; it += G - skip) { const bool smp = it >= 1024; const int i2 = it - 1024;
      gmlp_item(lds, p, l, smp ? TPR + (i2 >> 3) * DSEQ : (it >> 7) * SEQ + ((it >> 3) & 15) * 128, smp ? DSEQ : 128, it & 7, smp ? p.out + O_VS + (size_t)((l * 8 + (i2 >> 3)) * DSEQ) * 1024 : nullptr); }
}
__device__ __forceinline__ void mc_phase(LAS unsigned char* lds, const Lp& p, int l, bool dry) {
  const int bid = p.bid, G = p.G;
  for (int it = bid; it < 272; it += G) { const bool smp = it >= 256; const int i2 = it - 256;
    ssd_mc_item(lds, p, l, smp ? i2 >> 1 : it >> 5, smp ? 0 : (it >> 1) & 15, it & 1, smp); }
  const CvtJob j0{p.in[15] + (size_t)l * 2048 * 1024, (bf16_t*)(p.ws + WS_WOUT), 2048, 1024, 16, 512}, j1{p.in[18] + (size_t)l * 1024 * 4096, (bf16_t*)(p.ws + WS_WF1), 1024, 4096, 64, 1024},
               j2{p.in[19] + (size_t)l * 4096 * 1024, (bf16_t*)(p.ws + WS_WF2), 4096, 1024, 16, 1024};
  if (!dry) cvt_run(lds, j0, j1, j2, bid, G);
}
__global__ void __launch_bounds__(512, 2) mk_fwd(Params pa) {
  extern __shared__ __attribute__((aligned(16))) unsigned char shm[];
  LAS unsigned char* lds = (LAS unsigned char*)shm;
  if (threadIdx.x < 4) ((LAS unsigned*)(lds + XB_ST_OFF))[threadIdx.x] = 0u;
  __syncthreads();
  XcdBarrier xbar; xbar.bar = (unsigned*)(pa.ws + WS_BAR); xbar.x = 0; xbar.st = (volatile LAS unsigned*)(lds + XB_ST_OFF);
  for (int ph = pa.ph_lo; ph < pa.ph_hi; ++ph) {
    const int l = (ph - 1) / NK, k = (ph - 1) - l * NK;
#ifndef PROBE_REP
#define PROBE_REP 0
#endif
    const int nrep = (ph > 0 && ((PROBE_REP >> k) & 1)) ? 2 : 1;
    for (int rep = 0; rep < nrep; ++rep) {
    int z; asm volatile("s_mov_b32 %0, 0" : "=s"(z));
    const Lp p{InProxy{pa, z}, pa.ws + z, pa.out + z, (int)threadIdx.x + z, (int)blockIdx.x + z, (int)gridDim.x + z};
    const bool dry = rep + 1 < nrep;
    if (ph == 0) p0_phase(lds, p);
    else if (k == 0) {
      pg8::Gemm g{(const bf16_t*)(p.ws + WS_XB), (const bf16_t*)(p.ws + WS_WIN), TPR, NINP, 1024}; pg8::StaticOrder S; S.init(TPR, NINP, p.G, p.bid);
      EpiIn E{(bf16_t*)(p.ws + WS_UG), (bf16_t*)(p.ws + WS_VG), (bf16_t*)(p.ws + WS_Z), (bf16_t*)(p.ws + WS_XBC), (float*)(p.ws + WS_DT), (f32x2*)(p.ws + WS_VST)};
      pg8::gemm_phase<EpiIn, pg8::StaticOrder, false>(lds, g, S, E, nullptr);
      { const int first = p.G == 256 ? 192 : 0;
        if (p.bid >= first) for (int t = p.bid - first; t < 4 * (NINP / 64); t += p.G - first) skinny_task<4, 0>(lds, p, (const bf16_t*)(p.ws + WS_XB), (const bf16_t*)(p.ws + WS_WIN), 1024, t & 3, t >> 2); }
    } else if (k == 1) ma_phase(lds, p, l);
    else if (k == 2) ssd_scan_phase(p, l);
    else if (k == 3) mc_phase(lds, p, l, dry);
    else if (k == 4 || k == 7) {
      pg8::Gemm g{(const bf16_t*)(p.ws + (k == 4 ? WS_MIX : WS_H)), (const bf16_t*)(p.ws + (k == 4 ? WS_WOUT : WS_WF2)), TPR, 1024, k == 4 ? MIXW : DFF}; pg8::StaticOrder S; S.init(TPR, 1024, p.G, p.bid);
      EpiRes E{(const bf16_t*)(p.ws + WS_XB), dry ? (float*)(p.ws + (k == 4 ? WS_UG : WS_MIX)) : p.out};
      pg8::gemm_phase<EpiRes, pg8::StaticOrder, false>(lds, g, S, E, nullptr);
      if (!dry) for (int t = p.bid; t < 4 * 64; t += p.G) skinny_task<1, 1>(lds, p, g.A, g.Bt, g.K, t & 3, t >> 2);
    } else if (k == 6) {
      pg8::Gemm g{(const bf16_t*)(p.ws + WS_XB), (const bf16_t*)(p.ws + WS_WF1), TPR, DFF, 1024}; pg8::StaticOrder S; S.init(TPR, DFF, p.G, p.bid);
      EpiRelu2 E{(bf16_t*)(p.ws + WS_H)};
      pg8::gemm_phase<EpiRelu2, pg8::StaticOrder, false>(lds, g, S, E, nullptr);
      for (int t = p.bid; t < 4 * 64; t += p.G) skinny_task<4, 2>(lds, p, g.A, g.Bt, 1024, t & 3, t >> 2);
    } else {
      ln_phase(p, p.in[k == 5 ? 16 : 20] + l * 1024, p.in[k == 5 ? 17 : 21] + l * 1024, p.out, (k == 8 && l == DEPTH - 1 && !dry) ? p.out : nullptr, (bf16_t*)(p.ws + (dry ? WS_MIX : WS_XB)));
      if (k == 8 && l + 1 < DEPTH && !dry) { const CvtJob j0{p.in[4] + (size_t)(l + 1) * 1024 * NIN, (bf16_t*)(p.ws + WS_WIN), 1024, NIN, NINP / 64, 16 * (NINP / 64)}, jn{nullptr, nullptr, 64, 64, 1, 0}; cvt_run(lds, j0, jn, jn, p.bid, p.G); }
    }
    }
    if (ph + 1 < pa.ph_hi) {
      if (ph == 0) { cg::this_grid().sync(); xbar = xcd_barrier_post((unsigned*)(pa.ws + WS_BAR), (volatile LAS unsigned*)(lds + XB_ST_OFF)); }
      else xcd_barrier(xbar); }
  }
}

extern "C" void kernel_launch(void* const* d_in, const int* in_sizes, int n_in, void* d_out, int out_size, void* d_ws, size_t ws_size, hipStream_t stream) {
  static int grid = 0;
  if (grid == 0) {
    if (n_in != 22 || ws_size < WS_END) { fprintf(stderr, "kernel_launch: n_in %d ws %zu (need %zu)\n", n_in, ws_size, (size_t)WS_END); grid = -1; return; }
    int dev = 0, cus = 0, per_cu = 0;
    hipGetDevice(&dev); hipDeviceGetAttribute(&cus, hipDeviceAttributeMultiprocessorCount, dev);
    if (hipFuncSetAttribute((const void*)mk_fwd, hipFuncAttributeMaxDynamicSharedMemorySize, LDS_BYTES) != hipSuccess) { fprintf(stderr, "kernel_launch: hipFuncSetAttribute failed\n"); grid = -1; return; }
    if (hipOccupancyMaxActiveBlocksPerMultiprocessor(&per_cu, (const void*)mk_fwd, 512, LDS_BYTES) != hipSuccess || per_cu < 1) { fprintf(stderr, "kernel_launch: occupancy query gave %d\n", per_cu); per_cu = 1; }
    (void)hipGetLastError();
    grid = cus * per_cu;
  }
  if (grid < 0) return;
  Params p{};
  for (int i = 0; i < 22; ++i) p.in[i] = (const float*)d_in[i];
  p.out = (float*)d_out; p.ws = (unsigned char*)d_ws;
#if defined(MK_MULTI)
  for (int i = 0; i < NPH; ++i) { p.ph_lo = i; p.ph_hi = i + 1; hipLaunchKernelGGL(mk_fwd, dim3(grid), dim3(512), LDS_BYTES, stream, p); }
#else
  p.ph_lo = 0; p.ph_hi = NPH;
  void* args[] = {&p};
  hipError_t e = hipLaunchCooperativeKernel((const void*)mk_fwd, dim3(grid), dim3(512), args, LDS_BYTES, stream);
  if (e != hipSuccess) fprintf(stderr, "cooperative launch failed: %s (grid %d)\n", hipGetErrorString(e), grid);
#endif
}
```
